# Optimizing an MI355X kernel written in HIP

```python
import math
import jax, jax.numpy as jnp
from jax import lax
import numpy as np

D_MODEL = 1024
BATCH = 16
SEQ = 2048
DEPTH = 1

HEAD_DIM = 64
A_Q_HEADS = 8
A_KV_HEADS = 2
B_HEADS = 8
GRID_W = 64
ROPE_THETA = 10000.0
Q_BLOCK = 128
DIL_BRANCHES = ((128, 1), (512, 4), (2048, 16))
DIL_BLOCK = max(w // (2 * r) for w, r in DIL_BRANCHES)
N_BUCKETS = 32
BUCKET_MAX_DIST = 1024
D_FF = 4 * D_MODEL
EPS = 1e-6
NEG = -1e30
A_WIDTH = A_Q_HEADS * HEAD_DIM
A_KV_WIDTH = A_KV_HEADS * HEAD_DIM
B_WIDTH = B_HEADS * HEAD_DIM
IN_WIDTH = A_WIDTH + 2 * A_KV_WIDTH + 3 * B_WIDTH
MIX_WIDTH = A_WIDTH + B_WIDTH

kernel_name = "hybrid_axial_gqa_dilated_attn_block"


def rms_norm(x, g):
    xf = x.astype(jnp.float32)
    y = xf * lax.rsqrt(jnp.mean(xf * xf, axis=-1, keepdims=True) + EPS)
    return (y * g.astype(jnp.float32)).astype(x.dtype)


def axial_rope_tables(S):
    ROWS = S // GRID_W
    row = jnp.repeat(jnp.arange(ROWS, dtype=jnp.float32), GRID_W)
    col = jnp.tile(jnp.arange(GRID_W, dtype=jnp.float32), ROWS)
    n_freq = HEAD_DIM // 4
    inv = ROPE_THETA ** (-jnp.arange(n_freq, dtype=jnp.float32) / n_freq)
    ang_r = row[:, None] * inv[None, :]
    ang_c = col[:, None] * inv[None, :]
    return jnp.cos(ang_r), jnp.sin(ang_r), jnp.cos(ang_c), jnp.sin(ang_c)


def rotate_half(x, cos, sin):
    x1, x2 = jnp.split(x, 2, axis=-1)
    return jnp.concatenate([x1 * cos - x2 * sin, x2 * cos + x1 * sin], axis=-1)


def axial_rope(x, tabs):
    cos_r, sin_r, cos_c, sin_c = tabs
    xf = x.astype(jnp.float32)
    a = HEAD_DIM // 2
    y = jnp.concatenate([rotate_half(xf[..., :a], cos_r, sin_r),
                         rotate_half(xf[..., a:], cos_c, sin_c)], axis=-1)
    return y.astype(x.dtype)


def gqa_axial_attention(q, k, v, gq, gk):
    B, S = q.shape[0], q.shape[1]
    tabs = axial_rope_tables(S)
    q = axial_rope(rms_norm(q, gq).transpose(0, 2, 1, 3), tabs)
    k = axial_rope(rms_norm(k, gk).transpose(0, 2, 1, 3), tabs)
    v = v.transpose(0, 2, 1, 3)
    G = A_Q_HEADS // A_KV_HEADS
    nb = S // Q_BLOCK
    q = q * (HEAD_DIM ** -0.5)
    qb = q.reshape(B, A_KV_HEADS, G, nb, Q_BLOCK, HEAD_DIM).transpose(3, 0, 1, 2, 4, 5)

    def block(qi):
        s = jnp.einsum('bkgqd,bksd->bkgqs', qi, k).astype(jnp.float32)
        p = jax.nn.softmax(s, axis=-1).astype(v.dtype)
        return jnp.einsum('bkgqs,bksd->bkgqd', p, v)

    o = lax.map(block, qb)
    return o.transpose(1, 0, 4, 2, 3, 5).reshape(B, S, A_WIDTH)


def t5_bucket(rel):
    nb_half = N_BUCKETS // 2
    max_exact = nb_half // 2
    ret = jnp.where(rel > 0, nb_half, 0)
    n = jnp.abs(rel)
    large = max_exact + (jnp.log(jnp.maximum(n, 1).astype(jnp.float32) / max_exact)
                         / math.log(BUCKET_MAX_DIST / max_exact)
                         * (nb_half - max_exact)).astype(jnp.int32)
    large = jnp.minimum(large, nb_half - 1)
    return ret + jnp.where(n < max_exact, n, large)


def band_blocks(xp, nb, qb):
    Bq, H, r, _, D = xp.shape
    parts = [xp[:, :, :, j * qb:j * qb + nb * qb].reshape(Bq, H, r, nb, qb, D) for j in range(3)]
    return jnp.concatenate(parts, axis=4)


def dilated_branch(q, k, v, rel_bias, window, dilation):
    B, H, S, D = q.shape
    r = dilation
    L = S // r
    half = window // (2 * r)
    Qb = DIL_BLOCK
    nb = -(-L // Qb)
    Lp = nb * Qb

    def to_phase(t):
        return t.reshape(B, H, L, r, D).transpose(0, 1, 3, 2, 4)

    qp = jnp.pad(to_phase(q), ((0, 0), (0, 0), (0, 0), (0, Lp - L), (0, 0))).reshape(B, H, r, nb, Qb, D)
    pad_kv = ((0, 0), (0, 0), (0, 0), (Qb, Lp - L + Qb), (0, 0))
    kb = band_blocks(jnp.pad(to_phase(k), pad_kv), nb, Qb)
    vb = band_blocks(jnp.pad(to_phase(v), pad_kv), nb, Qb)

    kk = jnp.arange(3 * Qb)
    qq = jnp.arange(Qb)
    rel = kk[None, :] - Qb - qq[:, None]
    kpos = jnp.arange(nb)[:, None] * Qb + kk[None, :] - Qb
    mask = (jnp.abs(rel) <= half)[None] & ((kpos >= 0) & (kpos < L))[:, None, :]
    bias = rel_bias[t5_bucket(rel * r)].transpose(2, 0, 1).astype(jnp.float32)

    s = jnp.einsum('bhrnqd,bhrnkd->bhrnqk', qp, kb).astype(jnp.float32) + bias[:, None, None]
    s = jnp.where(mask, s, NEG)
    m = jnp.max(s, axis=-1, keepdims=True)
    e = jnp.exp(s - m)
    den = jnp.sum(e, axis=-1, keepdims=True)
    o = jnp.einsum('bhrnqk,bhrnkd->bhrnqd', e, vb.astype(jnp.float32)) / den
    lse = (m + jnp.log(den))[..., 0]
    o = o.reshape(B, H, r, Lp, D)[:, :, :, :L].transpose(0, 1, 3, 2, 4).reshape(B, H, S, D)
    lse = lse.reshape(B, H, r, Lp)[:, :, :, :L].transpose(0, 1, 3, 2).reshape(B, H, S)
    return o, lse


def dilated_mixture_attention(q, k, v, rel_bias):
    B, S = q.shape[0], q.shape[1]
    q = q.transpose(0, 2, 1, 3) * (HEAD_DIM ** -0.5)
    k = k.transpose(0, 2, 1, 3)
    v = v.transpose(0, 2, 1, 3)
    outs, lses = [], []
    for window, dilation in DIL_BRANCHES:
        o, l = dilated_branch(q, k, v, rel_bias, window, dilation)
        outs.append(o)
        lses.append(l)
    alpha = jax.nn.softmax(jnp.stack(lses, axis=0), axis=0)
    y = jnp.einsum('nbhs,nbhsd->bhsd', alpha, jnp.stack(outs, axis=0))
    return y.transpose(0, 2, 1, 3).reshape(B, S, B_WIDTH).astype(v.dtype)


def setup_inputs(seed: int = 0) -> dict:
    key = jax.random.key(seed)
    ks = jax.random.split(key, 16)
    f32 = jnp.float32

    def gain(k, shape):
        return jnp.ones(shape, f32) + 0.05 * jax.random.normal(k, shape, f32)

    return {
        "x": jax.random.normal(ks[0], (BATCH, SEQ, D_MODEL), f32),
        "attn_norm_g": gain(ks[1], (DEPTH, D_MODEL)),
        "w_in": jax.random.normal(ks[2], (DEPTH, D_MODEL, IN_WIDTH), f32) * D_MODEL ** -0.5,
        "q_norm_g": gain(ks[3], (DEPTH, HEAD_DIM)),
        "k_norm_g": gain(ks[4], (DEPTH, HEAD_DIM)),
        "rel_bias": 0.5 * jax.random.normal(ks[5], (N_BUCKETS, B_HEADS), f32),
        "out_norm_a_g": gain(ks[6], (DEPTH, A_WIDTH)),
        "out_norm_b_g": gain(ks[7], (DEPTH, B_WIDTH)),
        "w_out": jax.random.normal(ks[8], (DEPTH, MIX_WIDTH, D_MODEL), f32) * MIX_WIDTH ** -0.5,
        "mlp_norm_g": gain(ks[9], (DEPTH, D_MODEL)),
        "w_up": jax.random.normal(ks[10], (DEPTH, D_MODEL, D_FF), f32) * D_MODEL ** -0.5,
        "w_down": jax.random.normal(ks[11], (DEPTH, D_FF, D_MODEL), f32) * D_FF ** -0.5,
        "final_norm_g": gain(ks[12], (D_MODEL,)),
    }


def reference(x, attn_norm_g, w_in, q_norm_g, k_norm_g, rel_bias, out_norm_a_g, out_norm_b_g,
              w_out, mlp_norm_g, w_up, w_down, final_norm_g):
    B, S, _ = x.shape
    h = x
    o1 = A_WIDTH
    o2 = o1 + A_KV_WIDTH
    o3 = o2 + A_KV_WIDTH
    o4 = o3 + B_WIDTH
    o5 = o4 + B_WIDTH
    for l in range(DEPTH):
        n = rms_norm(h, attn_norm_g[l])
        proj = jnp.einsum('bsd,de->bse', n, w_in[l])
        qa = proj[..., :o1].reshape(B, S, A_Q_HEADS, HEAD_DIM)
        ka = proj[..., o1:o2].reshape(B, S, A_KV_HEADS, HEAD_DIM)
        va = proj[..., o2:o3].reshape(B, S, A_KV_HEADS, HEAD_DIM)
        qb = proj[..., o3:o4].reshape(B, S, B_HEADS, HEAD_DIM)
        kb = proj[..., o4:o5].reshape(B, S, B_HEADS, HEAD_DIM)
        vb = proj[..., o5:].reshape(B, S, B_HEADS, HEAD_DIM)
        ya = gqa_axial_attention(qa, ka, va, q_norm_g[l], k_norm_g[l])
        yb = dilated_mixture_attention(qb, kb, vb, rel_bias)
        mix = jnp.concatenate([rms_norm(ya, out_norm_a_g[l]), rms_norm(yb, out_norm_b_g[l])], axis=-1)
        h = h + jnp.einsum('bse,ed->bsd', mix, w_out[l])
        u = jnp.einsum('bsd,df->bsf', rms_norm(h, mlp_norm_g[l]), w_up[l])
        h = h + jnp.einsum('bsf,fd->bsd', jnp.square(jax.nn.relu(u)), w_down[l])
    return rms_norm(h, final_norm_g)
```

```cpp
#include <hip/hip_runtime.h>
#include <cstdio>
#include <cstdint>
namespace pg8 {
#define PG8_LAS __attribute__((address_space(3)))
typedef unsigned short bf16_t;
typedef short bf16x8 __attribute__((ext_vector_type(8)));
typedef float f32x4 __attribute__((ext_vector_type(4)));
typedef unsigned u32x4 __attribute__((ext_vector_type(4)));
constexpr int BM = 256, BK = 64, HALF = 128, HTB = HALF * BK * 2  , STAGE_BYTES = 8 * HTB, NXCD = 8, WGM = 8;

__host__ __device__ __forceinline__ int lds_byte(int r, int c) { const int st = (r >> 4) * 2 + (c >> 5), rr = r & 15, cc = c & 31, ob = rr * 64 + cc * 2; return st * 1024 + (ob ^ (((ob >> 9) & 1) << 5)); }
__host__ __device__ __forceinline__ void stage_rc(int b, int& R, int& C) { const int st = b / 1024, sb = b % 1024, swz = sb ^ (((sb >> 9) & 1) << 5); R = (st >> 1) * 16 + swz / 64; C = (st & 1) * 32 + (swz % 64) / 2; }
__host__ __device__ __forceinline__ int perm32(int rho) { const int n = rho >> 4, i = rho & 15; return 8 * (i >> 2) + 4 * n + (i & 3); }

struct Unit { int pm, pn; };
struct Gemm { const bf16_t* A; const bf16_t* Bt; int M, N, K; };

struct StaticOrder {
    int nM, nN, nwg, G, c;
    __host__ __device__ void init(int M, int N, int G_, int c_) { nM = M / BM; nN = N / BM; nwg = nM * nN; G = G_; c = c_; }
    __host__ __device__ bool next(int i, Unit& u) const {
        const long L = (long)i * G + c; if (L >= nwg) return false;
        int wgid = (int)L; { const int q = nwg / NXCD, r = nwg % NXCD, xcd = wgid % NXCD, off = wgid / NXCD; wgid = (xcd < r ? xcd * (q + 1) : r * (q + 1) + (xcd - r) * q) + off; }
        const int nig = WGM * nN, gid = wgid / nig, fm = gid * WGM, gsz = (nM - fm) < WGM ? (nM - fm) : WGM;
        u.pm = fm + ((wgid % nig) % gsz); u.pn = (wgid % nig) / gsz; return true;
    }
    __device__ __forceinline__ void a_ready(const Unit&) const {}
    __device__ __forceinline__ void done(const Unit&) const {}
};

__device__ __forceinline__ unsigned cvt_pk_bf16(float lo, float hi) { unsigned r; asm volatile("v_cvt_pk_bf16_f32 %0, %1, %2" : "=v"(r) : "v"(lo), "v"(hi)); return r; }
typedef unsigned u32x2 __attribute__((ext_vector_type(2)));

struct EpiQKV {
    static constexpr bool PERM = true, AFTER_DRAIN = false;
    bf16_t *QA, *KA, *VA, *QB, *KB, *VB; const float *gq, *gk, *cosT, *sinT;
    __device__ __forceinline__ void operator()(const f32x4 (&acc)[2][2][4][2], const Unit& u, int wr, int wc, int fr, int fq) const {
        const int row0 = u.pm * BM + wr * 64 + fr;
        const int colh = u.pn * BM + wc * 64;
        bf16_t* dst; int ldd, coff, type;
        if (colh < 512)       { dst = QA; ldd = 512; coff = colh;        type = 0; }
        else if (colh < 640)  { dst = KA; ldd = 128; coff = colh - 512;  type = 1; }
        else if (colh < 768)  { dst = VA; ldd = 128; coff = colh - 640;  type = 2; }
        else if (colh < 1280) { dst = QB; ldd = 512; coff = colh - 768;  type = 3; }
        else if (colh < 1792) { dst = KB; ldd = 512; coff = colh - 1280; type = 2; }
        else                  { dst = VB; ldd = 512; coff = colh - 1792; type = 2; }
        const float C2 = 0.125f * 1.4426950408889634f;
        if (type <= 1) {
            const float* g = (type == 0) ? gq : gk;
            f32x4 gv[2][2];
#pragma unroll
            for (int bj = 0; bj < 2; ++bj)
#pragma unroll
                for (int n = 0; n < 2; ++n) gv[bj][n] = *(const f32x4*)(g + 32 * bj + 8 * fq + 4 * n);
            const float sc = (type == 0) ? C2 : 1.f;
            const int f0 = 8 * (fq & 1);
            const float sgn = (fq < 2) ? -1.f : 1.f;
#pragma unroll
            for (int ai = 0; ai < 2; ++ai)
#pragma unroll
                for (int m = 0; m < 4; ++m) {
                    const int row = row0 + ai * HALF + m * 16; const int t = row & 2047;
                    float ss = 0.f;
#pragma unroll
                    for (int bj = 0; bj < 2; ++bj)
#pragma unroll
                        for (int n = 0; n < 2; ++n) { const f32x4 x = acc[ai][bj][m][n]; ss += (x[0] * x[0] + x[1] * x[1]) + (x[2] * x[2] + x[3] * x[3]); }
                    ss += __shfl_xor(ss, 16); ss += __shfl_xor(ss, 32);
                    const float rs = sc / sqrtf(ss * (1.0f / 64.0f) + 1e-6f);
#pragma unroll
                    for (int bj = 0; bj < 2; ++bj) {
                        const int pos = bj ? 32 + (t & 63) : (t >> 6);
                        f32x4 y[2];
#pragma unroll
                        for (int n = 0; n < 2; ++n) {
                            const f32x4 c4 = *(const f32x4*)(cosT + pos * 16 + f0 + 4 * n), s4 = *(const f32x4*)(sinT + pos * 16 + f0 + 4 * n);
                            const f32x4 yy = acc[ai][bj][m][n] * gv[bj][n] * rs; f32x4 pr;
#pragma unroll
                            for (int e = 0; e < 4; ++e) pr[e] = __shfl_xor(yy[e], 32);
                            y[n] = yy * c4 + pr * s4 * sgn;
                        }
                        u32x4 w; w.x = cvt_pk_bf16(y[0][0], y[0][1]); w.y = cvt_pk_bf16(y[0][2], y[0][3]); w.z = cvt_pk_bf16(y[1][0], y[1][1]); w.w = cvt_pk_bf16(y[1][2], y[1][3]);
                        *(u32x4*)(dst + (size_t)row * ldd + coff + 32 * bj + 8 * fq) = w;
                    }
                }
        } else {
            const float sc = (type == 3) ? C2 : 1.f;
#pragma unroll
            for (int ai = 0; ai < 2; ++ai)
#pragma unroll
                for (int m = 0; m < 4; ++m) {
                    const int row = row0 + ai * HALF + m * 16;
#pragma unroll
                    for (int bj = 0; bj < 2; ++bj) {
                        const f32x4 v0 = acc[ai][bj][m][0] * sc, v1 = acc[ai][bj][m][1] * sc;
                        u32x4 w; w.x = cvt_pk_bf16(v0[0], v0[1]); w.y = cvt_pk_bf16(v0[2], v0[3]); w.z = cvt_pk_bf16(v1[0], v1[1]); w.w = cvt_pk_bf16(v1[2], v1[3]);
                        *(u32x4*)(dst + (size_t)row * ldd + coff + 32 * bj + 8 * fq) = w;
                    }
                }
        }
    }
};
template <bool WRITE_BF> struct EpiRes {
    static constexpr bool PERM = false, AFTER_DRAIN = false;
    const float* base; float* out; bf16_t* hb; float* ss;
    __device__ __forceinline__ void operator()(const f32x4 (&acc)[2][2][4][2], const Unit& u, int wr, int wc, int fr, int fq) const {
        const int row0 = u.pm * BM + wr * 64 + fr, col0 = u.pn * BM + wc * 32 + 4 * fq;
#pragma unroll
        for (int ai = 0; ai < 2; ++ai)
#pragma unroll
            for (int m = 0; m < 4; ++m) {
                const int row = row0 + ai * HALF + m * 16; const size_t off = (size_t)row * 1024 + col0; float q = 0.f;
#pragma unroll
                for (int bj = 0; bj < 2; ++bj)
#pragma unroll
                    for (int n = 0; n < 2; ++n) {
                        const size_t c = off + bj * HALF + n * 16;
                        const f32x4 h = *(const f32x4*)(base + c) + acc[ai][bj][m][n];
                        *(f32x4*)(out + c) = h; q += (h[0] * h[0] + h[1] * h[1]) + (h[2] * h[2] + h[3] * h[3]);
                        if (WRITE_BF) { u32x2 w; w.x = cvt_pk_bf16(h[0], h[1]); w.y = cvt_pk_bf16(h[2], h[3]); *(u32x2*)(hb + c) = w; }
                    }
                q += __shfl_xor(q, 16); q += __shfl_xor(q, 32);
                if (fq == 0) atomicAdd(ss + row, q);
            }
    }
};
struct EpiUp {
    static constexpr bool PERM = true, AFTER_DRAIN = false;
    bf16_t* U; const float* ss;
    __device__ __forceinline__ void operator()(const f32x4 (&acc)[2][2][4][2], const Unit& u, int wr, int wc, int fr, int fq) const {
        const int row0 = u.pm * BM + wr * 64 + fr, col0 = u.pn * BM + wc * 32 + 8 * fq;
#pragma unroll
        for (int ai = 0; ai < 2; ++ai)
#pragma unroll
            for (int m = 0; m < 4; ++m) {
                const int row = row0 + ai * HALF + m * 16; const float rs = 1.0f / sqrtf(ss[row] * (1.0f / 1024.0f) + 1e-6f);
                bf16_t* rowp = U + (size_t)row * 4096 + col0;
#pragma unroll
                for (int bj = 0; bj < 2; ++bj) {
                    f32x4 v0 = acc[ai][bj][m][0] * rs, v1 = acc[ai][bj][m][1] * rs;
#pragma unroll
                    for (int e = 0; e < 4; ++e) { const float a = fmaxf(v0[e], 0.f), b = fmaxf(v1[e], 0.f); v0[e] = a * a; v1[e] = b * b; }
                    u32x4 w; w.x = cvt_pk_bf16(v0[0], v0[1]); w.y = cvt_pk_bf16(v0[2], v0[3]); w.z = cvt_pk_bf16(v1[0], v1[1]); w.w = cvt_pk_bf16(v1[2], v1[3]);
                    *(u32x4*)(rowp + bj * HALF) = w;
                }
            }
    }
};

template <class Epi, class Sched, bool ALIGN_EPI = false, bool SP2 = false>
__device__ __forceinline__ void gemm_phase(PG8_LAS unsigned char* lds, const Gemm g, const Sched& S, const Epi& E) {
    int tid_ = threadIdx.x; asm volatile("" : "+v"(tid_));
    const int tid = tid_, wid = __builtin_amdgcn_readfirstlane(tid >> 6), lane = tid & 63, wr = wid >> 2, wc = wid & 3, fr = lane & 15, fq = lane >> 4;
    const int K = g.K, nt = K / BK;
    unsigned voffA[2], voffB[2];
#pragma unroll
    for (int i = 0; i < 2; ++i) { int R, C; stage_rc(tid * 16 + i * 8192, R, C); const int Rb = Epi::PERM ? ((R & ~31) + perm32(R & 31)) : R;
        voffA[i] = (unsigned)(R * K + C) * 2u; voffB[i] = (unsigned)(Rb * K + C) * 2u; }
    const size_t kstep = (size_t)(BK * 2);
    const size_t hstep = (size_t)HALF * K * 2;
    const size_t tstep = 2 * hstep;
    const unsigned ldsw = (unsigned)wid * 1024u;
    const int aoff = lds_byte(wr * 64 + fr, fq * 8), boff = lds_byte(wc * 32 + fr, fq * 8);
#define PG8_SA(b, h) (((b) * 2 + (h)) * HTB)
#define PG8_SB(b, h) ((4 + (b) * 2 + (h)) * HTB)
#define PG8_STAGE(bufoff, gbase, voff) do { _Pragma("unroll") for (int _i = 0; _i < 2; ++_i) \
        __builtin_amdgcn_global_load_lds((const unsigned*)((const char*)(gbase) + (voff)[_i]), (PG8_LAS unsigned*)(lds + (bufoff) + ldsw + _i * 8192), 16, 0, 0); } while (0)
#define PG8_LDA(dst, b, h) do { _Pragma("unroll") for (int m = 0; m < 4; ++m) _Pragma("unroll") for (int k = 0; k < 2; ++k) dst[m][k] = *(const PG8_LAS bf16x8*)(lds + PG8_SA(b, h) + aoff + m * 2048 + k * 1024); } while (0)
#define PG8_LDB(dst, b, h) do { _Pragma("unroll") for (int n = 0; n < 2; ++n) _Pragma("unroll") for (int k = 0; k < 2; ++k) dst[n][k] = *(const PG8_LAS bf16x8*)(lds + PG8_SB(b, h) + boff + n * 2048 + k * 1024); } while (0)
#define PG8_MMA(ai, bj, At, Bt) do { __builtin_amdgcn_s_setprio(1); _Pragma("unroll") for (int m = 0; m < 4; ++m) _Pragma("unroll") for (int n = 0; n < 2; ++n) _Pragma("unroll") for (int k = 0; k < 2; ++k) \
        acc[ai][bj][m][n] = __builtin_amdgcn_mfma_f32_16x16x32_bf16(Bt[n][k], At[m][k], acc[ai][bj][m][n], 0, 0, 0); __builtin_amdgcn_s_setprio(0); } while (0)
#define PG8_WAIT_V(n) asm volatile("s_waitcnt vmcnt(" #n ")" ::: "memory")
#define PG8_WAIT_L(n) asm volatile("s_waitcnt lgkmcnt(" #n ")" ::: "memory")
#define PG8_BAR __builtin_amdgcn_s_barrier()
#define PG8_SCHED __builtin_amdgcn_sched_barrier(0)
    Unit cur, nxt; int ui = 0;
    if (!S.next(0, cur)) return;
    f32x4 acc[2][2][4][2];
#pragma unroll
    for (int a = 0; a < 2; ++a)
#pragma unroll
        for (int b = 0; b < 2; ++b)
#pragma unroll
            for (int m = 0; m < 4; ++m)
#pragma unroll
                for (int n = 0; n < 2; ++n) acc[a][b][m][n] = (f32x4){0.f, 0.f, 0.f, 0.f};
    bf16x8 At[4][2], B0[2][2], B1[2][2];
    const char* cA = (const char*)g.A + (size_t)cur.pm * tstep; const char* cB = (const char*)g.Bt + (size_t)cur.pn * tstep;
    S.a_ready(cur);
    if constexpr (SP2) {
        PG8_STAGE(PG8_SB(0, 0), cB, voffB); PG8_STAGE(PG8_SB(0, 1), cB + hstep, voffB); PG8_STAGE(PG8_SA(0, 0), cA, voffA); PG8_STAGE(PG8_SA(0, 1), cA + hstep, voffA);
        if (wr == 1) PG8_BAR;
        PG8_WAIT_V(2); PG8_BAR;
        PG8_STAGE(PG8_SB(1, 0), cB + kstep, voffB); PG8_STAGE(PG8_SA(1, 0), cA + kstep, voffA); PG8_STAGE(PG8_SB(1, 1), cB + hstep + kstep, voffB);
        PG8_WAIT_V(6); PG8_BAR;
    } else {
        PG8_STAGE(PG8_SB(0, 0), cB, voffB); PG8_STAGE(PG8_SA(0, 0), cA, voffA); PG8_STAGE(PG8_SB(0, 1), cB + hstep, voffB); PG8_STAGE(PG8_SA(0, 1), cA + hstep, voffA);
        if (wr == 1) PG8_BAR;
        PG8_WAIT_V(4); PG8_BAR;
        PG8_STAGE(PG8_SB(1, 0), cB + kstep, voffB); PG8_STAGE(PG8_SA(1, 0), cA + kstep, voffA); PG8_STAGE(PG8_SB(1, 1), cB + hstep + kstep, voffB);
        PG8_WAIT_V(6); PG8_BAR;
    }
    for (;;) {
        const bool has_next = S.next(ui + 1, nxt);
        const char* nA = has_next ? (const char*)g.A + (size_t)nxt.pm * tstep : cA; const char* nB = has_next ? (const char*)g.Bt + (size_t)nxt.pn * tstep : cB;
        for (int t = 0; t < nt; t += 2) {
            const bool last = (t == nt - 2);
            const char* a1 = cA + (size_t)(t + 1) * kstep;
            const char* a2 = last ? nA : cA + (size_t)(t + 2) * kstep; const char* b2 = last ? nB : cB + (size_t)(t + 2) * kstep;
            const char* a3 = a2 + kstep; const char* b3 = b2 + kstep;
            if (last && has_next) S.a_ready(nxt);
            if constexpr (SP2) {
            PG8_LDB(B0, 0, 0); PG8_LDB(B1, 0, 1); PG8_SCHED; PG8_LDA(At, 0, 0); PG8_STAGE(PG8_SA(1, 1), a1 + hstep, voffA);
            PG8_WAIT_V(8); PG8_WAIT_L(0); PG8_BAR; PG8_MMA(0, 0, At, B0); PG8_MMA(0, 1, At, B1); PG8_BAR; PG8_SCHED;
            PG8_LDA(At, 0, 1); PG8_STAGE(PG8_SB(0, 0), b2, voffB); PG8_STAGE(PG8_SB(0, 1), b2 + hstep, voffB); PG8_STAGE(PG8_SA(0, 0), a2, voffA);
            PG8_WAIT_V(8); PG8_WAIT_L(0); PG8_BAR; PG8_MMA(1, 0, At, B0); PG8_MMA(1, 1, At, B1); PG8_BAR; PG8_SCHED;
            PG8_LDB(B0, 1, 0); PG8_LDB(B1, 1, 1); PG8_SCHED; PG8_LDA(At, 1, 0); PG8_STAGE(PG8_SA(0, 1), a2 + hstep, voffA);
            PG8_WAIT_V(8); PG8_WAIT_L(0); PG8_BAR; PG8_MMA(0, 0, At, B0); PG8_MMA(0, 1, At, B1); PG8_BAR; PG8_SCHED;
            PG8_LDA(At, 1, 1); PG8_STAGE(PG8_SB(1, 0), b3, voffB); PG8_STAGE(PG8_SB(1, 1), b3 + hstep, voffB); PG8_STAGE(PG8_SA(1, 0), a3, voffA);
            PG8_WAIT_V(8); PG8_WAIT_L(0); PG8_BAR; PG8_MMA(1, 0, At, B0); PG8_MMA(1, 1, At, B1); PG8_BAR; PG8_SCHED;
            } else {
            PG8_LDB(B0, 0, 0); PG8_SCHED; PG8_LDA(At, 0, 0); PG8_STAGE(PG8_SA(1, 1), a1 + hstep, voffA);
            PG8_WAIT_L(8); PG8_BAR; PG8_WAIT_L(0); PG8_MMA(0, 0, At, B0); PG8_BAR; PG8_SCHED;
            PG8_LDB(B1, 0, 1); PG8_STAGE(PG8_SB(0, 0), b2, voffB);
            PG8_BAR; PG8_WAIT_L(0); PG8_MMA(0, 1, At, B1); PG8_BAR;
            PG8_LDA(At, 0, 1); PG8_STAGE(PG8_SA(0, 0), a2, voffA);
            PG8_BAR; PG8_WAIT_L(0); PG8_MMA(1, 0, At, B0); PG8_BAR; PG8_SCHED;
            PG8_STAGE(PG8_SB(0, 1), b2 + hstep, voffB);
            PG8_WAIT_V(6); PG8_BAR; PG8_MMA(1, 1, At, B1); PG8_BAR;
            PG8_LDB(B0, 1, 0); PG8_SCHED; PG8_LDA(At, 1, 0); PG8_STAGE(PG8_SA(0, 1), a2 + hstep, voffA);
            PG8_WAIT_L(8); PG8_BAR; PG8_WAIT_L(0); PG8_MMA(0, 0, At, B0); PG8_BAR; PG8_SCHED;
            PG8_LDB(B1, 1, 1); PG8_STAGE(PG8_SB(1, 0), b3, voffB);
            PG8_BAR; PG8_WAIT_L(0); PG8_MMA(0, 1, At, B1); PG8_BAR;
            PG8_LDA(At, 1, 1); PG8_STAGE(PG8_SA(1, 0), a3, voffA);
            PG8_BAR; PG8_WAIT_L(0); PG8_MMA(1, 0, At, B0); PG8_BAR; PG8_SCHED;
            PG8_STAGE(PG8_SB(1, 1), b3 + hstep, voffB);
            PG8_WAIT_V(6); PG8_BAR; PG8_MMA(1, 1, At, B1); PG8_BAR;
            }
        }
        if constexpr (ALIGN_EPI) { if (wr == 0) PG8_BAR; }
        if constexpr (!Epi::AFTER_DRAIN) { E(acc, cur, wr, wc, fr, fq); S.done(cur); }
        if (!has_next) break;
#pragma unroll
        for (int a = 0; a < 2; ++a)
#pragma unroll
            for (int b = 0; b < 2; ++b)
#pragma unroll
                for (int m = 0; m < 4; ++m)
#pragma unroll
                    for (int n = 0; n < 2; ++n) acc[a][b][m][n] = (f32x4){0.f, 0.f, 0.f, 0.f};
        cur = nxt; cA = nA; cB = nB; ++ui;
        if constexpr (ALIGN_EPI) { if (wr == 1) PG8_BAR; }
    }
    PG8_WAIT_V(0);
    if constexpr (!ALIGN_EPI) { if (wr == 0) PG8_BAR; }
    PG8_BAR;
    if constexpr (Epi::AFTER_DRAIN) { E.fused(acc, cur, wr, wc, fr, fq, lds, wid, lane); S.done(cur); }
#undef PG8_SA
#undef PG8_SB
#undef PG8_STAGE
#undef PG8_LDA
#undef PG8_LDB
#undef PG8_MMA
#undef PG8_WAIT_V
#undef PG8_WAIT_L
#undef PG8_BAR
#undef PG8_SCHED
}
}

#ifndef PG8_SP2
#define PG8_SP2 true
#endif
#ifndef PG8_ALIGN
#define PG8_ALIGN true
#endif
#include <hip/hip_bf16.h>
#include <cmath>
namespace attn_body {
using bf16=__hip_bfloat16;
using bf16x8=__attribute__((ext_vector_type(8)))short;
using s16x4=__attribute__((ext_vector_type(4)))short;
using f32x16=__attribute__((ext_vector_type(16)))float;
using u32x4=__attribute__((ext_vector_type(4)))unsigned;
constexpr int BATCH=16,NHEAD=8,NKV=2,SEQ=2048,D=64,QP=NHEAD*D,KP=NKV*D,OP=1024;
constexpr int NW=8,QBLK=32,QB=QBLK*NW,KVBLK=64,NQB=SEQ/QB;
constexpr int ATTN_UNIT_ROWS=QB;
__device__ __forceinline__ int crow(int r,int hi){return (r&3)+8*(r>>2)+4*hi;}
#define SBAR() __builtin_amdgcn_sched_barrier(0)
__device__ __forceinline__ void cmask(f32x16&p0,f32x16&p1,int jb,int qrel,int hi){
  const float NEG=-INFINITY; int kb=64*jb+4*hi;
  #pragma unroll
  for(int r=0;r<16;++r){int kv=kb+(r&3)+8*(r>>2); if(kv>qrel)p0[r]=NEG; if(kv+32>qrel)p1[r]=NEG;}
}

constexpr int NSLOT=3, SLOTB=8192;
constexpr int LDS_K=0, LDS_V=NSLOT*SLOTB, LDS_WS=2*NSLOT*SLOTB, LDS_OST=LDS_WS+NW*64*4, LDS_BYTES=LDS_OST+NW*4096;
constexpr float C2=0.125f*1.4426950408889634f;
__device__ __forceinline__ void glds16(const void*gsrc,unsigned lds_dst){unsigned keep;
  asm volatile("s_mov_b32 %0, m0\n\ts_mov_b32 m0, %2\n\ts_nop 0\n\tglobal_load_lds_dwordx4 %1, off\n\ts_mov_b32 m0, %0":"=&s"(keep):"v"(gsrc),"s"(lds_dst):"memory");}
__device__ __forceinline__ float max3f(float a,float b,float c){float r;asm("v_max3_f32 %0, %1, %2, %3":"=v"(r):"v"(a),"v"(b),"v"(c));return r;}
__device__ __forceinline__ float max2f(float a,float b){float r;asm("v_max_f32_e32 %0, %1, %2":"=v"(r):"v"(a),"v"(b));return r;}
__device__ __forceinline__ float fadd_s(float a,float b){float r;asm("v_add_f32_e32 %0, %1, %2":"=v"(r):"v"(a),"v"(b));return r;}
__device__ __forceinline__ float fsub_s(float a,float b){float r;asm("v_sub_f32_e32 %0, %1, %2":"=v"(r):"v"(a),"v"(b));return r;}
typedef float f32x2_t __attribute__((ext_vector_type(2))); typedef __bf16 bf16x2_t __attribute__((ext_vector_type(2)));
__device__ __forceinline__ unsigned cvtpk_s(float lo,float hi){f32x2_t v={lo,hi};bf16x2_t b=__builtin_convertvector(v,bf16x2_t);return __builtin_bit_cast(unsigned,b);}
#define WAIT_BAR(N) asm volatile("s_waitcnt vmcnt(" #N ") lgkmcnt(0)\n\ts_barrier":::"memory")

__device__ __forceinline__ void qkt(f32x16&p0,f32x16&p1,const char*Kslot,const bf16x8*qr,const f32x16&negm,int r32,int hi){
  const char*kb=Kslot+hi*1024+r32*16;
  #pragma unroll
  for(int d0=0;d0<4;++d0){
    const bf16x8 b0=*reinterpret_cast<const bf16x8*>(kb+d0*2048);
    const bf16x8 b1=*reinterpret_cast<const bf16x8*>(kb+d0*2048+512);
    if(d0==0){p0=__builtin_amdgcn_mfma_f32_32x32x16_bf16(b0,qr[0],negm,0,0,0);p1=__builtin_amdgcn_mfma_f32_32x32x16_bf16(b1,qr[0],negm,0,0,0);}
    else{p0=__builtin_amdgcn_mfma_f32_32x32x16_bf16(b0,qr[d0],p0,0,0,0);p1=__builtin_amdgcn_mfma_f32_32x32x16_bf16(b1,qr[d0],p1,0,0,0);}}
}
typedef __attribute__((address_space(3))) const char* lds_cptr;
typedef short v4i16_t __attribute__((ext_vector_type(4)));
__device__ __forceinline__ void kload8(bf16x8*kf,lds_cptr kp){
  kf[0]=*(const __attribute__((address_space(3))) bf16x8*)(kp);      kf[1]=*(const __attribute__((address_space(3))) bf16x8*)(kp+512);
  kf[2]=*(const __attribute__((address_space(3))) bf16x8*)(kp+2048); kf[3]=*(const __attribute__((address_space(3))) bf16x8*)(kp+2560);
  kf[4]=*(const __attribute__((address_space(3))) bf16x8*)(kp+4096); kf[5]=*(const __attribute__((address_space(3))) bf16x8*)(kp+4608);
  kf[6]=*(const __attribute__((address_space(3))) bf16x8*)(kp+6144); kf[7]=*(const __attribute__((address_space(3))) bf16x8*)(kp+6656);
}
__device__ __forceinline__ void kload2(bf16x8*kf,lds_cptr kp,int j){ kf[2*j]=*(const __attribute__((address_space(3))) bf16x8*)(kp+j*2048); kf[2*j+1]=*(const __attribute__((address_space(3))) bf16x8*)(kp+j*2048+512); }
__device__ __forceinline__ s16x4 vtr(lds_cptr p){ return __builtin_bit_cast(s16x4,__builtin_amdgcn_ds_read_tr16_b64_v4i16((__attribute__((address_space(3))) v4i16_t*)p)); }
__device__ __forceinline__ float rowmax(const f32x16&p0,const f32x16&p1){
  float a=max3f(p0[0],p0[1],p1[0]),b=max3f(p0[2],p0[3],p1[1]);a=max3f(a,p1[2],p1[3]);
  #pragma unroll
  for(int r=4;r<16;r+=4){a=max3f(a,p0[r],p0[r+1]);b=max3f(b,p0[r+2],p0[r+3]);a=max3f(a,p1[r],p1[r+1]);b=max3f(b,p1[r+2],p1[r+3]);}
  const float m=max2f(a,b);
  auto rr=__builtin_amdgcn_permlane32_swap(__float_as_uint(m),__float_as_uint(m),false,false);
  return max2f(__uint_as_float(rr[0]),__uint_as_float(rr[1]));
}
__device__ __forceinline__ void pv(f32x16*o,int vb,bf16x8 pa0,bf16x8 pa1,bf16x8 pa2,bf16x8 pa3){
  #pragma unroll
  for(int d0=0;d0<2;++d0){s16x4 lo[4],hi[4];
    #pragma unroll
    for(int ks=0;ks<4;++ks){
      asm volatile("ds_read_b64_tr_b16 %0,%1 offset:%c2":"=&v"(lo[ks]):"v"(vb),"i"(d0*4096+ks*1024):"memory");
      asm volatile("ds_read_b64_tr_b16 %0,%1 offset:%c2":"=&v"(hi[ks]):"v"(vb),"i"(d0*4096+ks*1024+512):"memory");}
    asm volatile("s_waitcnt lgkmcnt(0)":::"memory");SBAR();
    #define PK(k) (bf16x8){lo[k][0],lo[k][1],lo[k][2],lo[k][3],hi[k][0],hi[k][1],hi[k][2],hi[k][3]}
    o[d0]=__builtin_amdgcn_mfma_f32_32x32x16_bf16(pa0,PK(0),o[d0],0,0,0);
    o[d0]=__builtin_amdgcn_mfma_f32_32x32x16_bf16(pa1,PK(1),o[d0],0,0,0);
    o[d0]=__builtin_amdgcn_mfma_f32_32x32x16_bf16(pa2,PK(2),o[d0],0,0,0);
    o[d0]=__builtin_amdgcn_mfma_f32_32x32x16_bf16(pa3,PK(3),o[d0],0,0,0);
    #undef PK
  }
}

#ifndef ATTN_STORE16
#define ATTN_STORE16(p,v) (*(u32x4*)(p)=(v))
#endif
template<int THRL> __device__ __forceinline__ void attn_unit(int b,int h,int kvh,int qb,const bf16*Q,const bf16*__restrict__ K,const bf16*__restrict__ V,bf16*O,char*shm){
  int tid_=threadIdx.x; asm volatile("":"+v"(tid_)); const int tid=tid_,lane=tid&63,r32=lane&31,hi=lane>>5; const int wid=__builtin_amdgcn_readfirstlane(tid>>6);
  const long rowbase=(long)b*SEQ; const int q0=qb*QB;
  const bf16*Qw=Q+(rowbase+q0+wid*QBLK)*QP+h*D;
  const bf16*Kh=K+rowbase*KP+kvh*D,*Vh=V+rowbase*KP+kvh*D;
  const unsigned lds0=(unsigned)(uintptr_t)shm;
  float*wsf=(float*)(shm+LDS_WS)+wid*64;
  const bf16*ksrc=Kh+(long)lane*KP+wid*8;
  const bf16*vsrc=Vh+(long)(16*(wid&3)+(lane>>2))*KP+(wid>>2)*32+(lane&3)*8;
  const unsigned kdst=lds0+LDS_K+wid*1024, vdst=lds0+LDS_V+wid*1024;
  #define DMA_K(t,slot) glds16(ksrc+(long)(t)*KVBLK*KP,(unsigned)__builtin_amdgcn_readfirstlane(kdst+(slot)))
  #define DMA_V(t,slot) glds16(vsrc+(long)(t)*KVBLK*KP,(unsigned)__builtin_amdgcn_readfirstlane(vdst+(slot)))
  const int vb0=(int)(lds0+LDS_V)+((lane>>4)&1)*32+(lane&3)*8+(4*hi+((lane&15)>>2))*64;
  const char*Kbase=shm+LDS_K; bf16x8 kf[8];
  const lds_cptr shm3=(lds_cptr)shm; const lds_cptr kp0=shm3+LDS_K+hi*1024+r32*16; const lds_cptr vp0=shm3+LDS_V+((lane>>4)&1)*32+(lane&3)*8+(4*hi+((lane&15)>>2))*64;
  constexpr int NT=SEQ/KVBLK;
  DMA_K(0,0);DMA_V(0,0);DMA_K(1,SLOTB);
  bf16x8 qr[4];
  #pragma unroll
  for(int d0=0;d0<4;++d0)qr[d0]=*reinterpret_cast<const bf16x8*>(&Qw[(long)r32*QP+d0*16+hi*8]);
  float mhat=0.f,l_reg=0.f;f32x16 o[2];o[0]=f32x16{};o[1]=f32x16{};f32x16 negm=f32x16{};asm volatile("":"+v"(negm));
  #define CMASK(P0,P1,t) do{}while(0)
  bool resc=false;
  #define START(P0,P1) do{ const float rm=rowmax(P0,P1); resc=false; \
    { const float dl=rm; mhat=fadd_s(mhat,dl); \
      _Pragma("unroll") for(int r=0;r<16;++r){P0[r]=fsub_s(P0[r],dl);P1[r]=fsub_s(P1[r],dl);} \
      _Pragma("unroll") for(int r=0;r<16;++r)negm[r]=-mhat; asm volatile("":"+v"(negm)); } \
    _Pragma("unroll") for(int r=0;r<16;++r)P0[r]=__builtin_amdgcn_exp2f(P0[r]); }while(0)
  #define RESC() do{ if(resc){ asm volatile("s_waitcnt lgkmcnt(0)":::"memory"); \
      _Pragma("unroll") for(int d_=0;d_<2;++d_) _Pragma("unroll") for(int r=0;r<16;++r)o[d_][r]*=wsf[crow(r,hi)]; } }while(0)
  f32x16 pA0,pA1,pB0,pB1;
  int sl_prev=0,sl_cur=0,sl_next=SLOTB;
  #define ROT() do{sl_prev=sl_cur;sl_cur=sl_next;sl_next=(sl_next==(NSLOT-1)*SLOTB)?0:sl_next+SLOTB;}while(0)
  DMA_K(2,2*SLOTB);
  WAIT_BAR(3);
  qkt(pA0,pA1,Kbase,qr,negm,r32,hi);asm volatile("s_nop 15\n\ts_nop 7":"+v"(pA0),"+v"(pA1));CMASK(pA0,pA1,0);
  START(pA0,pA1);
  _Pragma("unroll") for(int r=0;r<16;++r)pA1[r]=__builtin_amdgcn_exp2f(pA1[r]);
  WAIT_BAR(0);
  DMA_K(3,0);DMA_V(1,SLOTB);
  ROT();
  kload8(kf,kp0+sl_cur);
  WAIT_BAR(2);
  s16x4 vlo[8],vhi[8]; u32x4 pw0,pw1,pw2,pw3;
  #define PKW(P,B) cvtpk_s(P[B],P[B+1])
  #define PAF(k) __builtin_bit_cast(bf16x8,pw##k)
  #define VFR(i) (bf16x8){vlo[i][0],vlo[i][1],vlo[i][2],vlo[i][3],vhi[i][0],vhi[i][1],vhi[i][2],vhi[i][3]}
  #define PIN(x) asm volatile("":"+v"(x))
  #define MX3(a,b,c) __builtin_fmaxf(__builtin_fmaxf((a),(b)),(c))
  #define GAPA(MF,A0,A1,A2,A3,W0,W1,PW) do{ MF; sacc+=A0; sacc+=A1; sacc+=A2; sacc+=A3; PIN(sacc); W0; W1; PIN(PW); SBAR(); }while(0)
  #define EX(v) __builtin_amdgcn_exp2f(v)
  #define GAPB(MF,X,B) do{ MF; X[B]=EX(X[B]); X[B+1]=EX(X[B+1]); X[B+2]=EX(X[B+2]); X[B+3]=EX(X[B+3]); PIN(X); SBAR(); }while(0)
  #define VRD(i) do{ vlo[i]=vtr(vp_+(((i)>>2)*4096+((i)&3)*1024)); vhi[i]=vtr(vp_+(((i)>>2)*4096+((i)&3)*1024+512)); }while(0)
  #define KRD(G,j) do{ if(G){ kload2(kf,kp0+sl_next,j); SBAR(); } }while(0)
  #define STEP(C0,C1,P0,P1,t,GK,GV,GL) do{ SBAR(); \
    const lds_cptr vp_=vp0+sl_prev; \
    VRD(0); SBAR(); float sacc=(P0[0]+P0[1]); \
    GAPA(C0=__builtin_amdgcn_mfma_f32_32x32x16_bf16(kf[0],qr[0],negm,0,0,0), P0[2],P0[3],P0[4],P0[5],     pw0[0]=PKW(P0,0), pw0[1]=PKW(P0,2), pw0); \
    VRD(4); SBAR(); GAPA(C1=__builtin_amdgcn_mfma_f32_32x32x16_bf16(kf[1],qr[0],negm,0,0,0), P0[6],P0[7],P0[8],P0[9],     pw0[2]=PKW(P0,4), pw0[3]=PKW(P0,6), pw0); \
    VRD(1); SBAR(); GAPA(C0=__builtin_amdgcn_mfma_f32_32x32x16_bf16(kf[2],qr[1],C0,0,0,0),   P0[10],P0[11],P0[12],P0[13], pw1[0]=PKW(P0,8), pw1[1]=PKW(P0,10), pw1); \
    VRD(5); SBAR(); GAPA(C1=__builtin_amdgcn_mfma_f32_32x32x16_bf16(kf[3],qr[1],C1,0,0,0),   P0[14],P0[15],P1[0],P1[1],   pw1[2]=PKW(P0,12),pw1[3]=PKW(P0,14), pw1); \
    VRD(2); SBAR(); GAPA(C0=__builtin_amdgcn_mfma_f32_32x32x16_bf16(kf[4],qr[2],C0,0,0,0),   P1[2],P1[3],P1[4],P1[5],     pw2[0]=PKW(P1,0), pw2[1]=PKW(P1,2), pw2); \
    VRD(6); SBAR(); GAPA(C1=__builtin_amdgcn_mfma_f32_32x32x16_bf16(kf[5],qr[2],C1,0,0,0),   P1[6],P1[7],P1[8],P1[9],     pw2[2]=PKW(P1,4), pw2[3]=PKW(P1,6), pw2); \
    VRD(3); SBAR(); GAPA(C0=__builtin_amdgcn_mfma_f32_32x32x16_bf16(kf[6],qr[3],C0,0,0,0),   P1[10],P1[11],P1[12],P1[13], pw3[0]=PKW(P1,8), pw3[1]=PKW(P1,10), pw3); \
    VRD(7); SBAR(); GAPA(C1=__builtin_amdgcn_mfma_f32_32x32x16_bf16(kf[7],qr[3],C1,0,0,0),   P1[14],P1[15],0.f,0.f,       pw3[2]=PKW(P1,12),pw3[3]=PKW(P1,14), pw3); \
    l_reg+=sacc; \
    if(GK){DMA_K((t)+3,sl_cur);} if(GV){DMA_V((t)+1,sl_next);} \
    CMASK(C0,C1,t); \
    { float a=MX3(C0[0],C0[1],C1[0]),b=MX3(C0[2],C0[3],C1[1]); a=MX3(a,C1[2],C1[3]); \
      _Pragma("unroll") for(int r=4;r<16;r+=4){a=MX3(a,C0[r],C0[r+1]);b=MX3(b,C0[r+2],C0[r+3]);a=MX3(a,C1[r],C1[r+1]);b=MX3(b,C1[r+2],C1[r+3]);} \
      float rm=__builtin_fmaxf(a,b); { auto rr=__builtin_amdgcn_permlane32_swap(__float_as_uint(rm),__float_as_uint(rm),false,false); rm=__builtin_fmaxf(__uint_as_float(rr[0]),__uint_as_float(rr[1])); } \
      resc=false; \
      if(__builtin_expect(__any(rm>(float)THRL),0)){ const float dl=__builtin_fmaxf(rm,0.f); mhat+=dl; \
        _Pragma("unroll") for(int r=0;r<16;++r){C0[r]-=dl;C1[r]-=dl;} \
        _Pragma("unroll") for(int r=0;r<16;++r)negm[r]=-mhat; asm volatile("":"+v"(negm)); \
        const float f=__builtin_amdgcn_exp2f(-dl); l_reg*=f; if(hi==0)wsf[r32]=f; resc=true; } } \
    SBAR(); \
    GAPB(o[0]=__builtin_amdgcn_mfma_f32_32x32x16_bf16(PAF(0),VFR(0),o[0],0,0,0), C0,0); \
    GAPB(o[1]=__builtin_amdgcn_mfma_f32_32x32x16_bf16(PAF(0),VFR(4),o[1],0,0,0), C0,4); \
    KRD(GL,0); GAPB(o[0]=__builtin_amdgcn_mfma_f32_32x32x16_bf16(PAF(1),VFR(1),o[0],0,0,0), C0,8); \
    KRD(GL,1); GAPB(o[1]=__builtin_amdgcn_mfma_f32_32x32x16_bf16(PAF(1),VFR(5),o[1],0,0,0), C0,12); \
    KRD(GL,2); GAPB(o[0]=__builtin_amdgcn_mfma_f32_32x32x16_bf16(PAF(2),VFR(2),o[0],0,0,0), C1,0); \
    KRD(GL,3); GAPB(o[1]=__builtin_amdgcn_mfma_f32_32x32x16_bf16(PAF(2),VFR(6),o[1],0,0,0), C1,4); \
    GAPB(o[0]=__builtin_amdgcn_mfma_f32_32x32x16_bf16(PAF(3),VFR(3),o[0],0,0,0), C1,8); \
    GAPB(o[1]=__builtin_amdgcn_mfma_f32_32x32x16_bf16(PAF(3),VFR(7),o[1],0,0,0), C1,12); \
    }while(0)
  int t=1;
  #undef CMASK
  #define CMASK(P0,P1,t) do{}while(0)
  for(;t+5<NT;t+=2){
    STEP(pB0,pB1,pA0,pA1,t,true,true,true);     WAIT_BAR(2); RESC(); ROT();
    STEP(pA0,pA1,pB0,pB1,t+1,true,true,true);   WAIT_BAR(2); RESC(); ROT();
  }
  #define ENDW(tt) do{ if((tt)+3<NT){WAIT_BAR(2);} else if((tt)+2<NT){WAIT_BAR(1);} else {WAIT_BAR(0);} }while(0)
  for(;t+1<NT;t+=2){
    STEP(pB0,pB1,pA0,pA1,t,(t+3<NT),(t+1<NT),(t+1<NT));       ENDW(t);   RESC(); ROT();
    STEP(pA0,pA1,pB0,pB1,t+1,(t+4<NT),(t+2<NT),(t+2<NT));     ENDW(t+1); RESC(); ROT();
  }
  STEP(pB0,pB1,pA0,pA1,NT-1,false,false,false); RESC();
  { float sacc=pB0[0]+pB0[1]; _Pragma("unroll") for(int r=2;r<16;++r)sacc+=pB0[r]; _Pragma("unroll") for(int r=0;r<16;++r)sacc+=pB1[r]; l_reg+=sacc;
    pw0=(u32x4){PKW(pB0,0),PKW(pB0,2),PKW(pB0,4),PKW(pB0,6)};pw1=(u32x4){PKW(pB0,8),PKW(pB0,10),PKW(pB0,12),PKW(pB0,14)};pw2=(u32x4){PKW(pB1,0),PKW(pB1,2),PKW(pB1,4),PKW(pB1,6)};pw3=(u32x4){PKW(pB1,8),PKW(pB1,10),PKW(pB1,12),PKW(pB1,14)};
    SBAR(); pv(o,vb0+sl_cur,PAF(0),PAF(1),PAF(2),PAF(3)); }
  #undef PKW
  #undef PAF
  #undef VFR
  #undef PIN
  #undef MX3
  #undef GAPA
  #undef GAPB
  #undef EX
  #undef VRD
  #undef KRD
  #undef STEP
  #undef ENDW
  {auto rr=__builtin_amdgcn_permlane32_swap(__float_as_uint(l_reg),__float_as_uint(l_reg),false,false);l_reg=__uint_as_float(rr[0])+__uint_as_float(rr[1]);}
  if(hi==0)wsf[32+r32]=l_reg;asm volatile("s_waitcnt lgkmcnt(0)":::"memory");
  float rli[16];
  #pragma unroll
  for(int r=0;r<16;++r)rli[r]=__builtin_amdgcn_rcpf(wsf[32+crow(r,hi)]);
  bf16*Ow=O+(rowbase+q0+wid*QBLK)*OP+h*D;
  { bf16*stg=(bf16*)(shm+LDS_OST)+wid*2048;
    #pragma unroll
    for(int r=0;r<16;++r){const int orow=crow(r,hi);
      #pragma unroll
      for(int d0=0;d0<2;++d0)stg[orow*64+d0*32+r32]=__float2bfloat16(o[d0][r]*rli[r]);}
    asm volatile("s_waitcnt lgkmcnt(0)":::"memory");
    #pragma unroll
    for(int i=0;i<4;++i){const int row=i*8+(lane>>3),ch=lane&7; const u32x4 v=*(const u32x4*)(stg+row*64+ch*8); ATTN_STORE16(Ow+(long)row*OP+ch*8,v);} }
  asm volatile("s_waitcnt lgkmcnt(0)\n\ts_barrier":::"memory");
  #undef DMA_K
  #undef DMA_V
  #undef CMASK
  #undef START
  #undef RESC
  #undef ROT
}
constexpr int ATTN_LDS_BYTES=LDS_BYTES;
#undef SBAR
#undef WAIT_BAR
}

namespace dil {
#define DIL_LAS __attribute__((address_space(3)))
typedef unsigned short bf16_t;
typedef short bf16x8 __attribute__((ext_vector_type(8)));
typedef short s16x4 __attribute__((ext_vector_type(4)));
typedef short v4i16_t __attribute__((ext_vector_type(4)));
typedef float f32x16 __attribute__((ext_vector_type(16)));
typedef unsigned u32x4 __attribute__((ext_vector_type(4)));
typedef unsigned u32x2 __attribute__((ext_vector_type(2)));
typedef float f32x2_t __attribute__((ext_vector_type(2))); typedef __bf16 bf16x2_t __attribute__((ext_vector_type(2)));
constexpr int SEQ = 2048, PITCH = 512, BT_STRIDE = 132;
__device__ __forceinline__ unsigned cvtpk(float lo, float hi) { f32x2_t v = {lo, hi}; bf16x2_t b = __builtin_convertvector(v, bf16x2_t); return __builtin_bit_cast(unsigned, b); }
__device__ __forceinline__ s16x4 vtr(const DIL_LAS char* p) { return __builtin_bit_cast(s16x4, __builtin_amdgcn_ds_read_tr16_b64_v4i16((DIL_LAS v4i16_t*)p)); }
__device__ __forceinline__ void unit(int b, int h, int r, int p, int qblk, const bf16_t* Q, const bf16_t* K, const bf16_t* V, bf16_t* PBr, float* LBr, DIL_LAS char* wl, const DIL_LAS float* btab) {
    int tid_ = threadIdx.x; asm volatile("" : "+v"(tid_));
    const int lane = tid_ & 63, r32 = lane & 31, hi = lane >> 5;
    const int L = SEQ / r, q0 = qblk * 32;
    const size_t rowb = (size_t)b * SEQ;
    const size_t qrow = rowb + (size_t)(q0 + r32) * r + p;
    const bf16_t* qp = Q + qrow * PITCH + h * 64 + hi * 8;
    bf16x8 qf[4];
#pragma unroll
    for (int ks = 0; ks < 4; ++ks) qf[ks] = *(const bf16x8*)(qp + ks * 16);
    const int k_lo = (q0 - 64 < 0) ? 0 : q0 - 64, k_hi = (q0 + 96 > L) ? L : q0 + 96;
    const int c = lane & 7, kr = lane >> 3;
    const bf16_t* Kb = K + rowb * PITCH + h * 64 + c * 8; const bf16_t* Vb = V + rowb * PITCH + h * 64 + c * 8;
    const int xs = lane >> 4;
    u32x4 kreg[4], vreg[4];
#define DIL_LOAD(k0_) do { _Pragma("unroll") for (int i = 0; i < 4; ++i) { const size_t e = (size_t)(((k0_) + 8 * i + kr) * r + p) * PITCH; kreg[i] = *(const u32x4*)(Kb + e); vreg[i] = *(const u32x4*)(Vb + e); } } while (0)
    DIL_LOAD(k_lo);
    float m = -1e30f, l = 0.f; f32x16 o0 = {}, o1 = {};
    const DIL_LAS char* kfp = wl + r32 * 128; const int kx = (r32 >> 1) & 7;
    const DIL_LAS char* vfp = wl + 4096 + ((lane >> 4) & 1) * 32 + (lane & 3) * 8 + (4 * hi + ((lane & 15) >> 2)) * 64;
    for (int k0 = k_lo; k0 < k_hi; k0 += 32) {
#pragma unroll
        for (int i = 0; i < 4; ++i) {
            const int key = 8 * i + kr;
            *(DIL_LAS u32x4*)(wl + key * 128 + ((c ^ (xs | (4 * (i & 1)))) * 16)) = kreg[i];
            *(DIL_LAS u32x4*)(wl + 4096 + (c >> 2) * 2048 + key * 64 + (c & 3) * 16) = vreg[i];
        }
        asm volatile("" ::: "memory");
        if (k0 + 32 < k_hi) DIL_LOAD(k0 + 32);
        f32x16 s = {};
#pragma unroll
        for (int ks = 0; ks < 4; ++ks) { const bf16x8 kf = *(const DIL_LAS bf16x8*)(kfp + (((2 * ks + hi) ^ kx) * 16)); s = __builtin_amdgcn_mfma_f32_32x32x16_bf16(kf, qf[ks], s, 0, 0, 0); }
        const int base = (k0 - q0) + 4 * hi - r32 + 65;
#pragma unroll
        for (int rr = 0; rr < 16; ++rr) { int idx = base + (rr & 3) + 8 * (rr >> 2); idx = idx < 0 ? 0 : (idx > 130 ? 130 : idx); s[rr] += btab[idx]; }
        float mt = s[0];
#pragma unroll
        for (int rr = 1; rr < 16; ++rr) mt = fmaxf(mt, s[rr]);
        { auto sw = __builtin_amdgcn_permlane32_swap(__float_as_uint(mt), __float_as_uint(mt), false, false); mt = fmaxf(__uint_as_float(sw[0]), __uint_as_float(sw[1])); }
        const float mn = fmaxf(m, mt), alpha = __builtin_amdgcn_exp2f(m - mn); m = mn;
        l *= alpha; o0 = o0 * alpha; o1 = o1 * alpha;
        float ps = 0.f;
#pragma unroll
        for (int rr = 0; rr < 16; ++rr) { s[rr] = __builtin_amdgcn_exp2f(s[rr] - mn); ps += s[rr]; }
        l += ps;
        u32x4 pw0, pw1;
        pw0.x = cvtpk(s[0], s[1]); pw0.y = cvtpk(s[2], s[3]); pw0.z = cvtpk(s[4], s[5]); pw0.w = cvtpk(s[6], s[7]);
        pw1.x = cvtpk(s[8], s[9]); pw1.y = cvtpk(s[10], s[11]); pw1.z = cvtpk(s[12], s[13]); pw1.w = cvtpk(s[14], s[15]);
        const bf16x8 pf0 = __builtin_bit_cast(bf16x8, pw0), pf1 = __builtin_bit_cast(bf16x8, pw1);
#pragma unroll
        for (int ks2 = 0; ks2 < 2; ++ks2) {
            const s16x4 a0 = vtr(vfp + ks2 * 1024), a1 = vtr(vfp + ks2 * 1024 + 512), b0 = vtr(vfp + 2048 + ks2 * 1024), b1 = vtr(vfp + 2048 + ks2 * 1024 + 512);
            const bf16x8 va = (bf16x8){a0[0], a0[1], a0[2], a0[3], a1[0], a1[1], a1[2], a1[3]}, vb = (bf16x8){b0[0], b0[1], b0[2], b0[3], b1[0], b1[1], b1[2], b1[3]};
            o0 = __builtin_amdgcn_mfma_f32_32x32x16_bf16(va, ks2 ? pf1 : pf0, o0, 0, 0, 0);
            o1 = __builtin_amdgcn_mfma_f32_32x32x16_bf16(vb, ks2 ? pf1 : pf0, o1, 0, 0, 0);
        }
        asm volatile("" ::: "memory");
    }
#undef DIL_LOAD
    { auto sw = __builtin_amdgcn_permlane32_swap(__float_as_uint(l), __float_as_uint(l), false, false); l = __uint_as_float(sw[0]) + __uint_as_float(sw[1]); }
    const float inv = 1.0f / l;
    if (hi == 0) LBr[qrow * 8 + h] = m + __builtin_amdgcn_logf(l);
    bf16_t* op = PBr + qrow * PITCH + h * 64 + 4 * hi;
#pragma unroll
    for (int g = 0; g < 4; ++g) {
        u32x2 w0, w1;
        w0.x = cvtpk(o0[4 * g] * inv, o0[4 * g + 1] * inv); w0.y = cvtpk(o0[4 * g + 2] * inv, o0[4 * g + 3] * inv);
        w1.x = cvtpk(o1[4 * g] * inv, o1[4 * g + 1] * inv); w1.y = cvtpk(o1[4 * g + 2] * inv, o1[4 * g + 3] * inv);
        *(u32x2*)(op + 8 * g) = w0; *(u32x2*)(op + 32 + 8 * g) = w1;
    }
}
}
constexpr int NWAVES = 8;
#ifndef MK_CHECK
#define MK_CHECK 0
#endif

constexpr int BATCH = 16, T = 2048, D = 1024, FF = 4096, NIN = 2304;
constexpr int M = BATCH * T;
constexpr float EPS = 1e-6f;
constexpr float LOG2E = 1.4426950408889634f;

constexpr size_t MiB = 1u << 20;
constexpr size_t WS_CTL = 0, CTL_ZERO_BYTES = 1 * MiB;
constexpr size_t WS_SSH = 256 * 1024, WS_SSO = 384 * 1024;
constexpr size_t WS_TAB = 1 * MiB;
constexpr size_t TAB_COS = 0, TAB_SIN = 6144, TAB_BIAS = 12288;
constexpr size_t WS_WIN = 2 * MiB, WS_WOUT = 8 * MiB, WS_WUP = 10 * MiB, WS_WDN = 18 * MiB;
constexpr size_t WS_HB = 32 * MiB;
constexpr size_t WS_XN = 96 * MiB;
constexpr size_t WS_QA = 160 * MiB, WS_KA = 192 * MiB, WS_VA = 200 * MiB;
constexpr size_t WS_QB = 208 * MiB, WS_KB = 240 * MiB, WS_VB = 272 * MiB;
constexpr size_t WS_Y = 304 * MiB;
constexpr size_t WS_PB = 368 * MiB;
constexpr size_t WS_LB = 464 * MiB;
constexpr size_t WS_U = 96 * MiB;
constexpr size_t WS_END = 468 * MiB;
static_assert(WS_U + (size_t)M * FF * 2 <= WS_PB && WS_LB + (size_t)3 * M * 8 * 4 <= WS_END && WS_WDN + (size_t)D * FF * 2 <= WS_HB, "d_ws map");
constexpr int CW_TMO = 0, CW_CODE = 1;
constexpr int CW_ERR = 64;
constexpr int CW_BAR = 4096;

constexpr int RING_OFF = 0, RING_BYTES = 131072;
constexpr int LDSCTL_OFF = RING_BYTES, MISC_OFF = LDSCTL_OFF + 320;
constexpr int LDS_BYTES = 147456;
static_assert(MISC_OFF + 128 <= LDS_BYTES, "LDS map");

static __device__ const unsigned char T5MAG[3][65] = {
  {0,1,2,3,4,5,6,7,8,8,8,8,8,8,8,9,9,9,9,9,9,9,9,9,9,9,9,10,10,10,10,10,10,10,10,10,10,10,10,10,10,10,10,10,10,10,10,10,10,10,11,11,11,11,11,11,11,11,11,11,11,11,11,11,11},
  {0,4,8,8,9,9,9,10,10,10,10,10,10,11,11,11,11,11,11,11,11,11,11,12,12,12,12,12,12,12,12,12,12,12,12,12,12,12,12,12,12,12,13,13,13,13,13,13,13,13,13,13,13,13,13,13,13,13,13,13,13,13,13,13,13},
  {0,9,10,10,11,11,12,12,12,12,12,13,13,13,13,13,13,13,13,13,14,14,14,14,14,14,14,14,14,14,14,14,14,14,14,15,15,15,15,15,15,15,15,15,15,15,15,15,15,15,15,15,15,15,15,15,15,15,15,15,15,15,15,15,15}};

#define GAS __attribute__((address_space(1)))
#define LAS __attribute__((address_space(3)))
typedef unsigned short bf16;
typedef unsigned v4u __attribute__((ext_vector_type(4)));
typedef float f32x4 __attribute__((ext_vector_type(4)));
typedef short bf16x8 __attribute__((ext_vector_type(8)));
typedef GAS unsigned gu32;
typedef GAS unsigned long long gu64;
#define RLX_AGENT __ATOMIC_RELAXED, __HIP_MEMORY_SCOPE_AGENT
#define LDS_WAIT() asm volatile("s_waitcnt lgkmcnt(0)" ::: "memory")
#define VM_WAIT() asm volatile("s_waitcnt vmcnt(0)" ::: "memory")
__device__ __forceinline__ unsigned long long rt() { return __builtin_amdgcn_s_memrealtime(); }
__device__ __forceinline__ unsigned f2bf(float f) { unsigned u = __builtin_bit_cast(unsigned, f); return (u + 0x7fffu + ((u >> 16) & 1u)) >> 16; }
__device__ __forceinline__ unsigned pk2(float lo, float hi) { return f2bf(lo) | (f2bf(hi) << 16); }

#define XB_TMO      128
#define XB_XCNT(j)  (256  + 64 * (j))
#define XB_XSUB(j)  (1280 + 64 * (j))
#define XB_XGEN(j)  (2304 + 64 * (j))
#define XB_TOP      3328
#define XB_TOPGEN   3392
#define XCD_BAR_WORDS 3456
#define XB_SPIN_CAP (1u << 18)

__device__ __forceinline__ unsigned xb_ld(unsigned* p)              { return __hip_atomic_load(p, __ATOMIC_RELAXED, __HIP_MEMORY_SCOPE_AGENT); }
__device__ __forceinline__ unsigned xb_add(unsigned* p, unsigned v) { return __hip_atomic_fetch_add(p, v, __ATOMIC_RELAXED, __HIP_MEMORY_SCOPE_AGENT); }
__device__ __forceinline__ unsigned xb_xcc_id() { return (unsigned)__builtin_amdgcn_s_getreg((3 << 11) | 20) & 0xFu; }
#define XB_SPIN(cond, bar) do { unsigned _sp = 0; while (cond) { __builtin_amdgcn_s_sleep(1); \
    if ((++_sp & 255u) == 0u) { if (xb_ld(&(bar)[XB_TMO])) break; if (_sp > XB_SPIN_CAP) { atomicAdd(&(bar)[XB_TMO], 1u); break; } } } } while (0)

struct XcdBarrier {
    unsigned* bar; unsigned x;
    volatile LAS unsigned* st;
};

__device__ __forceinline__ XcdBarrier xcd_barrier_post(unsigned* bar, volatile LAS unsigned* st) {
    XcdBarrier b; b.bar = bar; b.x = xb_xcc_id(); b.st = st;
    if (threadIdx.x == 0) (void)xb_add(&bar[XB_XCNT(b.x)], 1u);
    return b;
}
__device__ __forceinline__ void xcd_barrier_complete(unsigned* bar, unsigned x, unsigned& nloc, unsigned& nx) {
    const unsigned G = gridDim.x * gridDim.y * gridDim.z;
    unsigned sum, cnt, mine, sp = 0u;
    for (;;) {
        sum = 0u; cnt = 0u; mine = 0u;
#pragma unroll
        for (unsigned j = 0; j < 16; ++j) { const unsigned c = xb_ld(&bar[XB_XCNT(j)]); sum += c; cnt += (c > 0u) ? 1u : 0u; mine = (j == x) ? c : mine; }
        if (sum == G) break;
        __builtin_amdgcn_s_sleep(1);
        if ((++sp & 255u) == 0u) { if (xb_ld(&bar[XB_TMO])) break; if (sp > XB_SPIN_CAP) { atomicAdd(&bar[XB_TMO], 1u); break; } }
    }
    nloc = mine > 0u ? mine : 1u; nx = cnt > 0u ? cnt : 1u;
}

__device__ __forceinline__ void xcd_barrier(const XcdBarrier& b) {
    asm volatile("s_waitcnt vmcnt(0)" ::: "memory");
    __syncthreads();
    if (threadIdx.x == 0) {
        unsigned* bar = b.bar;
        __builtin_amdgcn_s_waitcnt(0);
        unsigned nloc = b.st[0], nx = b.st[1];
        if (nloc == 0u) { xcd_barrier_complete(bar, b.x, nloc, nx); b.st[0] = nloc; b.st[1] = nx; }
        const unsigned old = xb_add(&bar[XB_XSUB(b.x)], 1u);
        const unsigned gen = old / nloc;
        if (old + 1u == (gen + 1u) * nloc) {
            __builtin_amdgcn_fence(__ATOMIC_RELEASE, "agent");
            asm volatile("s_waitcnt vmcnt(0)" ::: "memory");
            const unsigned og = xb_add(&bar[XB_TOP], 1u);
            const unsigned tg = og / nx;
            if (og + 1u == (tg + 1u) * nx) xb_add(&bar[XB_TOPGEN], 1u);
            else XB_SPIN(xb_ld(&bar[XB_TOPGEN]) == tg, bar);
            __builtin_amdgcn_fence(__ATOMIC_ACQUIRE, "agent");
            xb_add(&bar[XB_XGEN(b.x)], 1u);
            asm volatile("s_waitcnt vmcnt(0)" ::: "memory");
        } else {
            XB_SPIN(xb_ld(&bar[XB_XGEN(b.x)]) == gen, bar);
            __builtin_amdgcn_fence(__ATOMIC_ACQUIRE, "agent");
            asm volatile("s_waitcnt vmcnt(0)" ::: "memory");
        }
    }
    __syncthreads();
}

struct Frame {
    LAS unsigned char* lds;
    volatile LAS unsigned* MISC;
    gu32* ctl;
    int tid, lane, wave;
    int vcu, G;
    const float *x, *g_attn, *w_in, *gq, *gk, *rel_bias, *g_oa, *g_ob, *w_out, *g_mlp, *w_up, *w_dn, *g_fin; float* out;
    bf16 *WinT, *WoutT, *WupT, *WdnT;
    bf16 *HB, *XN, *QA, *KA, *VA, *QB, *KB, *VB, *Y, *PB, *U;
    float *LB, *ssH, *ssO, *cosT, *sinT, *biasT;
};

__device__ __forceinline__ float wave_sum(float v) {
#pragma unroll
    for (int o = 1; o < 64; o <<= 1) v += __shfl_xor(v, o);
    return v;
}
__device__ __forceinline__ void sincos_small(float a, float& s, float& c) {
    const float k = rintf(a * 0.63661977236758134f);
    float r = fmaf(-k, 1.5707962512969971f, a); r = fmaf(-k, 7.5497894158615964e-08f, r); r = fmaf(-k, 5.3903025299577648e-15f, r);
    const float r2 = r * r;
    const float sp = r + r * r2 * (-1.6666666666666666e-1f + r2 * (8.3333333333333332e-3f + r2 * (-1.9841269841269841e-4f + r2 * 2.7557319223985893e-6f)));
    const float cp = 1.0f + r2 * (-0.5f + r2 * (4.1666666666666664e-2f + r2 * (-1.3888888888888889e-3f + r2 * (2.4801587301587302e-5f + r2 * -2.7557319223985888e-7f))));
    const int q = ((int)k) & 3;
    s = (q == 0) ? sp : (q == 1) ? cp : (q == 2) ? -sp : -cp;
    c = (q == 0) ? cp : (q == 1) ? -sp : (q == 2) ? -cp : sp;
}
template <bool PERMW> __device__ __forceinline__ void p0_transpose_item(const float* W, int K, int N, bf16* WT, const float* gk_, LAS float* scr, int item, int lane) {
    const int nblk = N / 32, kb = item / nblk, nb = item % nblk, k0 = 64 * kb, n0 = 32 * nb;
#pragma unroll 8
    for (int i = 0; i < 32; ++i) { const int kk = 2 * i + (lane >> 5); float w = W[(size_t)(k0 + kk) * N + n0 + (lane & 31)]; if (gk_) w *= gk_[k0 + kk]; scr[kk * 33 + (lane & 31)] = w; }
    LDS_WAIT(); asm volatile("" ::: "memory");
    int prow0 = n0;
    if (PERMW) { const int tile = n0 >> 8, cc = n0 & 255; prow0 = tile * 256 + 128 * ((cc & 63) >> 5) + 32 * (cc >> 6); }
    const int c = lane & 7;
#pragma unroll
    for (int j = 0; j < 4; ++j) { const int n = (lane >> 3) + 8 * j; const LAS float* s = scr + (8 * c) * 33 + n;
        v4u o; o.x = pk2(s[0 * 33], s[1 * 33]); o.y = pk2(s[2 * 33], s[3 * 33]); o.z = pk2(s[4 * 33], s[5 * 33]); o.w = pk2(s[6 * 33], s[7 * 33]);
        *(GAS v4u*)(WT + (size_t)(prow0 + n) * K + k0 + 8 * c) = o; }
    LDS_WAIT(); asm volatile("" ::: "memory");
}
__device__ __forceinline__ void p0_prologue(Frame& F_) {
    Frame F = F_; { int l_ = threadIdx.x; asm volatile("" : "+v"(l_)); F.tid = l_; F.lane = l_ & 63; }
    LAS float* scr = (LAS float*)(F.lds + RING_OFF + F.wave * 16384);
    const int gw = F.vcu * NWAVES + F.wave, NGW = F.G * NWAVES;
    constexpr int I_IN = (D / 64) * (NIN / 32), I_OUT = (D / 64) * (D / 32), I_UP = (D / 64) * (FF / 32), I_DN = (FF / 64) * (D / 32);
    constexpr int NITEMS = I_IN + I_OUT + I_UP + I_DN;
    for (int it = gw; it < NITEMS; it += NGW) {
        int r = it;
        if (r < I_IN) { p0_transpose_item<true>(F.w_in, D, NIN, F.WinT, nullptr, scr, r, F.lane); continue; } r -= I_IN;
        if (r < I_OUT) { p0_transpose_item<false>(F.w_out, D, D, F.WoutT, nullptr, scr, r, F.lane); continue; } r -= I_OUT;
        if (r < I_UP) { p0_transpose_item<false>(F.w_up, D, FF, F.WupT, F.g_mlp, scr, r, F.lane); continue; } r -= I_UP;
        p0_transpose_item<false>(F.w_dn, FF, D, F.WdnT, nullptr, scr, r, F.lane);
    }
    {
        const int gt = gw * 64 + F.lane;
        if (gt < 96 * 16) {
            const int pos = gt >> 4, f = gt & 15; const float p = (float)(pos < 32 ? pos : pos - 32);
            const float inv = __builtin_amdgcn_exp2f(-(float)f * (13.287712379549449f / 16.0f));
            float s, c; sincos_small(p * inv, s, c); F.cosT[gt] = c; F.sinT[gt] = s;
        }
        const int bt = gt - 2048;
        if (bt >= 0 && bt < 3 * 8 * 132) {
            const int br = bt / (8 * 132), h = (bt / 132) & 7, i = bt % 132; const int rel = i - 65, n = rel < 0 ? -rel : rel;
            float v = -1e30f;
            if (n <= 64) { const int bucket = (rel > 0 ? 16 : 0) + (int)T5MAG[br][n]; v = F.rel_bias[bucket * 8 + h] * LOG2E; }
            F.biasT[bt] = v;
        }
    }
    {
        f32x4 g[4];
#pragma unroll
        for (int j = 0; j < 4; ++j) g[j] = ((const GAS f32x4*)F.g_attn)[F.lane + 64 * j];
        for (int m = gw; m < M; m += NGW) {
            const GAS f32x4* xr = (const GAS f32x4*)(F.x + (size_t)m * D) + F.lane;
            f32x4 v[4]; float s2 = 0.f;
#pragma unroll
            for (int j = 0; j < 4; ++j) { v[j] = xr[64 * j]; s2 += (v[j].x * v[j].x + v[j].y * v[j].y) + (v[j].z * v[j].z + v[j].w * v[j].w); }
            const float rs = 1.f / sqrtf(wave_sum(s2) * (1.f / D) + EPS);
            GAS unsigned long long* o8 = (GAS unsigned long long*)(F.XN + (size_t)m * D) + F.lane;
#pragma unroll
            for (int j = 0; j < 4; ++j) { const f32x4 y = v[j] * rs * g[j]; o8[64 * j] = (unsigned long long)pk2(y.x, y.y) | ((unsigned long long)pk2(y.z, y.w) << 32); }
        }
    }
}
__device__ __forceinline__ f32x4 bf4_lo(v4u w, int half) {
    const unsigned a = half ? w.z : w.x, b = half ? w.w : w.y;
    return (f32x4){__uint_as_float(a << 16), __uint_as_float(a & 0xffff0000u), __uint_as_float(b << 16), __uint_as_float(b & 0xffff0000u)};
}
__device__ __forceinline__ void p2n_rows(Frame& F_) {
    Frame F = F_; { int l_ = threadIdx.x; asm volatile("" : "+v"(l_)); F.tid = l_; F.lane = l_ & 63; }
    const int gw = F.vcu * NWAVES + F.wave, NGW = F.G * NWAVES, l = F.lane;
    const f32x4 ga0 = ((const GAS f32x4*)F.g_oa)[2 * l], ga1 = ((const GAS f32x4*)F.g_oa)[2 * l + 1], gb0 = ((const GAS f32x4*)F.g_ob)[2 * l], gb1 = ((const GAS f32x4*)F.g_ob)[2 * l + 1];
    for (int m = gw; m < M; m += NGW) {
        GAS v4u* yr = (GAS v4u*)(F.Y + (size_t)m * 1024);
        const v4u wa = yr[l];
        v4u wp[3]; float ls[3];
#pragma unroll
        for (int r = 0; r < 3; ++r) { wp[r] = ((const GAS v4u*)(F.PB + ((size_t)r * M + m) * 512))[l]; ls[r] = F.LB[((size_t)r * M + m) * 8 + (l >> 3)]; }
        const float mx = fmaxf(fmaxf(ls[0], ls[1]), ls[2]);
        float w0 = __builtin_amdgcn_exp2f(ls[0] - mx), w1 = __builtin_amdgcn_exp2f(ls[1] - mx), w2 = __builtin_amdgcn_exp2f(ls[2] - mx);
        const float wi = 1.f / (w0 + w1 + w2); w0 *= wi; w1 *= wi; w2 *= wi;
        const f32x4 a0 = bf4_lo(wa, 0), a1 = bf4_lo(wa, 1);
        const f32x4 b0 = bf4_lo(wp[0], 0) * w0 + bf4_lo(wp[1], 0) * w1 + bf4_lo(wp[2], 0) * w2, b1 = bf4_lo(wp[0], 1) * w0 + bf4_lo(wp[1], 1) * w1 + bf4_lo(wp[2], 1) * w2;
        float sa = (a0.x * a0.x + a0.y * a0.y) + (a0.z * a0.z + a0.w * a0.w) + (a1.x * a1.x + a1.y * a1.y) + (a1.z * a1.z + a1.w * a1.w);
        float sb = (b0.x * b0.x + b0.y * b0.y) + (b0.z * b0.z + b0.w * b0.w) + (b1.x * b1.x + b1.y * b1.y) + (b1.z * b1.z + b1.w * b1.w);
        sa = wave_sum(sa); sb = wave_sum(sb);
        const float ra = 1.f / sqrtf(sa * (1.f / 512.f) + EPS), rb = 1.f / sqrtf(sb * (1.f / 512.f) + EPS);
        const f32x4 ya0 = a0 * ra * ga0, ya1 = a1 * ra * ga1, yb0 = b0 * rb * gb0, yb1 = b1 * rb * gb1;
        v4u oa, ob; oa.x = pk2(ya0.x, ya0.y); oa.y = pk2(ya0.z, ya0.w); oa.z = pk2(ya1.x, ya1.y); oa.w = pk2(ya1.z, ya1.w);
        ob.x = pk2(yb0.x, yb0.y); ob.y = pk2(yb0.z, yb0.w); ob.z = pk2(yb1.x, yb1.y); ob.w = pk2(yb1.z, yb1.w);
        yr[l] = oa; yr[64 + l] = ob;
    }
}
__device__ __forceinline__ void p6_rows(Frame& F_) {
    Frame F = F_; { int l_ = threadIdx.x; asm volatile("" : "+v"(l_)); F.tid = l_; F.lane = l_ & 63; }
    const int gw = F.vcu * NWAVES + F.wave, NGW = F.G * NWAVES;
    f32x4 g[4];
#pragma unroll
    for (int j = 0; j < 4; ++j) g[j] = ((const GAS f32x4*)F.g_fin)[F.lane + 64 * j];
    for (int m = gw; m < M; m += NGW) {
        GAS f32x4* xr = (GAS f32x4*)(F.out + (size_t)m * D) + F.lane;
        const float rs = 1.f / sqrtf(F.ssO[m] * (1.f / D) + EPS);
#pragma unroll
        for (int j = 0; j < 4; ++j) { const f32x4 v = xr[64 * j]; xr[64 * j] = v * rs * g[j]; }
    }
}

#if MK_CHECK
__device__ __forceinline__ float bf2f(bf16 v) { return __uint_as_float((unsigned)v << 16); }
__device__ __forceinline__ bool chk_close(float a, float ref, float atol, float rtol) { return fabsf(a - ref) <= atol + rtol * fabsf(ref); }
__device__ __forceinline__ void chk_flag(Frame& F, int k, bool bad) { if (__any(bad) && F.lane == 0) atomicAdd((unsigned*)(F.ctl + CW_ERR + k), 1u); }
__device__ __forceinline__ unsigned chk_hash(unsigned x) { x ^= x >> 16; x *= 0x7feb352du; x ^= x >> 15; x *= 0x846ca68bu; x ^= x >> 16; return x; }
__device__ __forceinline__ int win_prow(int n) { const int tile = n >> 8, cc = n & 255; return tile * 256 + 128 * ((cc & 63) >> 5) + 32 * (cc >> 6) + (cc & 31); }
__device__ __forceinline__ float chk_dot(const bf16* a, const bf16* b, int K, int lane) {
    float s = 0.f;
    for (int k = lane * 8; k < K; k += 512) { const v4u x = *(const GAS v4u*)(a + k), y = *(const GAS v4u*)(b + k);
        const f32x4 x0 = bf4_lo(x, 0), x1 = bf4_lo(x, 1), y0 = bf4_lo(y, 0), y1 = bf4_lo(y, 1);
        s += (x0.x * y0.x + x0.y * y0.y) + (x0.z * y0.z + x0.w * y0.w) + (x1.x * y1.x + x1.y * y1.y) + (x1.z * y1.z + x1.w * y1.w); }
    return wave_sum(s);
}
__device__ __forceinline__ void chk_p0(Frame& F_) {
    Frame F = F_; { int l_ = threadIdx.x; asm volatile("" : "+v"(l_)); F.tid = l_; F.lane = l_ & 63; }
    const int gw = F.vcu * NWAVES + F.wave, l = F.lane;
    { const int m = (int)(chk_hash(gw * 3 + 1) % M); float s2 = 0.f;
      for (int k = l; k < D; k += 64) { const float v = F.x[(size_t)m * D + k]; s2 += v * v; }
      const float rs = 1.f / sqrtf(wave_sum(s2) / D + EPS); bool bad = false;
      for (int k = l; k < D; k += 64) bad |= !chk_close(bf2f(F.XN[(size_t)m * D + k]), F.x[(size_t)m * D + k] * rs * F.g_attn[k], 0.01f, 0.01f);
      chk_flag(F, 0, bad); }
    { bool bad = false;
      for (int i = 0; i < 8; ++i) { const unsigned hsh = chk_hash((gw * 64 + l) * 8 + i);
          { const int n = hsh % NIN, k = (hsh >> 12) % D; bad |= !chk_close(bf2f(F.WinT[(size_t)win_prow(n) * D + k]), F.w_in[(size_t)k * NIN + n], 1e-4f, 0.005f); }
          { const int n = hsh % D, k = (hsh >> 12) % D; bad |= !chk_close(bf2f(F.WoutT[(size_t)n * D + k]), F.w_out[(size_t)k * D + n], 1e-4f, 0.005f); }
          { const int n = hsh % FF, k = (hsh >> 12) % D; bad |= !chk_close(bf2f(F.WupT[(size_t)n * D + k]), F.w_up[(size_t)k * FF + n] * F.g_mlp[k], 1e-4f, 0.005f); }
          { const int n = hsh % D, k = (hsh >> 12) % FF; bad |= !chk_close(bf2f(F.WdnT[(size_t)n * FF + k]), F.w_dn[(size_t)k * D + n], 1e-4f, 0.005f); } }
      chk_flag(F, 1, bad); }
}
__device__ __forceinline__ void chk_p1(Frame& F_) {
    Frame F = F_; { int l_ = threadIdx.x; asm volatile("" : "+v"(l_)); F.tid = l_; F.lane = l_ & 63; }
    const int gw = F.vcu * NWAVES + F.wave, l = F.lane;
    for (int it = 0; it < 4; ++it) {
        const unsigned hsh = chk_hash(gw * 4 + it + 77); const int row = hsh % M, slot = (hsh >> 16) % 36;
        const int n = slot * 64 + l; const bf16* a = F.XN + (size_t)row * D; const bf16* w = F.WinT + (size_t)win_prow(n) * D;
        float v = 0.f;
        for (int k = 0; k < D; k += 8) { const v4u x = *(const GAS v4u*)(a + k), y = *(const GAS v4u*)(w + k);
            const f32x4 x0 = bf4_lo(x, 0), x1 = bf4_lo(x, 1), y0 = bf4_lo(y, 0), y1 = bf4_lo(y, 1);
            v += (x0.x * y0.x + x0.y * y0.y) + (x0.z * y0.z + x0.w * y0.w) + (x1.x * y1.x + x1.y * y1.y) + (x1.z * y1.z + x1.w * y1.w); }
        const int col = slot * 64; float got; const float C2 = 0.125f * LOG2E;
        if (col < 640) {
            const float* g = col < 512 ? F.gq : F.gk; const float rs = 1.f / sqrtf(wave_sum(v * v) / 64.f + EPS); float y = v * rs * g[l];
            const int t = row & 2047, half = l >> 5, j = l & 31, f = j & 15; const float pos = half ? (float)(t & 63) : (float)(t >> 6);
            const float inv = powf(10000.f, -(float)f / 16.f); float sn, cs; sincos_small(pos * inv, sn, cs);
            const float pr = __shfl_xor(y, 16); y = (j < 16) ? y * cs - pr * sn : y * cs + pr * sn;
            if (col < 512) { y *= C2; got = bf2f(F.QA[(size_t)row * 512 + col + l]); } else got = bf2f(F.KA[(size_t)row * 128 + col - 512 + l]);
            v = y;
        } else if (col < 768) got = bf2f(F.VA[(size_t)row * 128 + col - 640 + l]);
        else if (col < 1280) { v *= C2; got = bf2f(F.QB[(size_t)row * 512 + col - 768 + l]); }
        else if (col < 1792) got = bf2f(F.KB[(size_t)row * 512 + col - 1280 + l]);
        else got = bf2f(F.VB[(size_t)row * 512 + col - 1792 + l]);
        chk_flag(F, 2, !chk_close(got, v, 0.02f, 0.02f));
    }
}
__device__ __forceinline__ void chk_p2(Frame& F_) {
    Frame F = F_; { int l_ = threadIdx.x; asm volatile("" : "+v"(l_)); F.tid = l_; F.lane = l_ & 63; }
    const int gw = F.vcu * NWAVES + F.wave, l = F.lane, hd = l >> 3, dg = l & 7;
    const unsigned hsh = chk_hash(gw + 4242); const int b = hsh % BATCH, t = (hsh >> 8) % T; const size_t row = (size_t)b * T + t;
    {
        const v4u qw = *(const GAS v4u*)(F.QA + row * 512 + hd * 64 + dg * 8); const f32x4 q0 = bf4_lo(qw, 0), q1 = bf4_lo(qw, 1);
        const int kvh = hd >> 2; float mx = -1e30f, den = 0.f; f32x4 o0 = {0, 0, 0, 0}, o1 = {0, 0, 0, 0};
        for (int k = 0; k < T; ++k) {
            const size_t kr = (size_t)b * T + k; const v4u kw = *(const GAS v4u*)(F.KA + kr * 128 + kvh * 64 + dg * 8), vw = *(const GAS v4u*)(F.VA + kr * 128 + kvh * 64 + dg * 8);
            const f32x4 k0 = bf4_lo(kw, 0), k1 = bf4_lo(kw, 1);
            float s = (q0.x * k0.x + q0.y * k0.y) + (q0.z * k0.z + q0.w * k0.w) + (q1.x * k1.x + q1.y * k1.y) + (q1.z * k1.z + q1.w * k1.w);
            s += __shfl_xor(s, 1); s += __shfl_xor(s, 2); s += __shfl_xor(s, 4);
            const float mn = fmaxf(mx, s), al = exp2f(mx - mn), p = exp2f(s - mn); mx = mn;
            den = den * al + p; o0 = o0 * al + bf4_lo(vw, 0) * p; o1 = o1 * al + bf4_lo(vw, 1) * p;
        }
        o0 = o0 / den; o1 = o1 / den;
        float ss = (o0.x * o0.x + o0.y * o0.y) + (o0.z * o0.z + o0.w * o0.w) + (o1.x * o1.x + o1.y * o1.y) + (o1.z * o1.z + o1.w * o1.w);
        const float rs = 1.f / sqrtf(wave_sum(ss) / 512.f + EPS); bool bad = false;
        const v4u yw = *(const GAS v4u*)(F.Y + row * 1024 + l * 8); const f32x4 y0 = bf4_lo(yw, 0), y1 = bf4_lo(yw, 1);
        for (int e = 0; e < 4; ++e) { bad |= !chk_close(y0[e], o0[e] * rs * F.g_oa[l * 8 + e], 0.03f, 0.03f); bad |= !chk_close(y1[e], o1[e] * rs * F.g_oa[l * 8 + 4 + e], 0.03f, 0.03f); }
        chk_flag(F, 3, bad);
    }
    {
        const v4u qw = *(const GAS v4u*)(F.QB + row * 512 + hd * 64 + dg * 8); const f32x4 q0 = bf4_lo(qw, 0), q1 = bf4_lo(qw, 1);
        float mx = -1e30f, den = 0.f; f32x4 o0 = {0, 0, 0, 0}, o1 = {0, 0, 0, 0};
        for (int br = 0; br < 3; ++br) { const int r = br == 0 ? 1 : br == 1 ? 4 : 16;
            for (int j = -64; j <= 64; ++j) { const int tk = t + j * r; if (tk < 0 || tk >= T) continue;
                const int rel = j * r, n = rel < 0 ? -rel : rel; int bucket = rel > 0 ? 16 : 0;
                if (n < 8) bucket += n; else { int lg = 8 + (int)(logf((float)n / 8.f) / logf(128.f) * 8.f); bucket += lg < 15 ? lg : 15; }
                const float bias = F.rel_bias[bucket * 8 + hd] * LOG2E;
                const size_t kr = (size_t)b * T + tk; const v4u kw = *(const GAS v4u*)(F.KB + kr * 512 + hd * 64 + dg * 8), vw = *(const GAS v4u*)(F.VB + kr * 512 + hd * 64 + dg * 8);
                const f32x4 k0 = bf4_lo(kw, 0), k1 = bf4_lo(kw, 1);
                float s = (q0.x * k0.x + q0.y * k0.y) + (q0.z * k0.z + q0.w * k0.w) + (q1.x * k1.x + q1.y * k1.y) + (q1.z * k1.z + q1.w * k1.w);
                s += __shfl_xor(s, 1); s += __shfl_xor(s, 2); s += __shfl_xor(s, 4); s += bias;
                const float mn = fmaxf(mx, s), al = exp2f(mx - mn), p = exp2f(s - mn); mx = mn;
                den = den * al + p; o0 = o0 * al + bf4_lo(vw, 0) * p; o1 = o1 * al + bf4_lo(vw, 1) * p; } }
        o0 = o0 / den; o1 = o1 / den;
        float ss = (o0.x * o0.x + o0.y * o0.y) + (o0.z * o0.z + o0.w * o0.w) + (o1.x * o1.x + o1.y * o1.y) + (o1.z * o1.z + o1.w * o1.w);
        const float rs = 1.f / sqrtf(wave_sum(ss) / 512.f + EPS); bool bad = false;
        const v4u yw = *(const GAS v4u*)(F.Y + row * 1024 + 512 + l * 8); const f32x4 y0 = bf4_lo(yw, 0), y1 = bf4_lo(yw, 1);
        for (int e = 0; e < 4; ++e) { bad |= !chk_close(y0[e], o0[e] * rs * F.g_ob[l * 8 + e], 0.03f, 0.03f); bad |= !chk_close(y1[e], o1[e] * rs * F.g_ob[l * 8 + 4 + e], 0.03f, 0.03f); }
        chk_flag(F, 4, bad);
    }
}
__device__ __forceinline__ void chk_p3(Frame& F_) {
    Frame F = F_; { int l_ = threadIdx.x; asm volatile("" : "+v"(l_)); F.tid = l_; F.lane = l_ & 63; }
    const int gw = F.vcu * NWAVES + F.wave, l = F.lane;
    for (int it = 0; it < 8; ++it) { const unsigned hsh = chk_hash(gw * 8 + it + 999); const int row = hsh % M, col = (hsh >> 16) % D;
        const float ref = F.x[(size_t)row * D + col] + chk_dot(F.Y + (size_t)row * D, F.WoutT + (size_t)col * D, D, l);
        chk_flag(F, 5, !chk_close(F.out[(size_t)row * D + col], ref, 0.03f, 0.02f) || !chk_close(bf2f(F.HB[(size_t)row * D + col]), ref, 0.04f, 0.02f)); }
    { const int row = (int)(chk_hash(gw + 31337) % M); float s2 = 0.f; for (int k = l; k < D; k += 64) { const float v = F.out[(size_t)row * D + k]; s2 += v * v; }
      s2 = wave_sum(s2); chk_flag(F, 6, !chk_close(F.ssH[row], s2, 0.f, 1e-3f)); }
}
__device__ __forceinline__ void chk_p4(Frame& F_) {
    Frame F = F_; { int l_ = threadIdx.x; asm volatile("" : "+v"(l_)); F.tid = l_; F.lane = l_ & 63; }
    const int gw = F.vcu * NWAVES + F.wave, l = F.lane;
    for (int it = 0; it < 8; ++it) { const unsigned hsh = chk_hash(gw * 8 + it + 5555); const int row = hsh % M, col = (hsh >> 16) % FF;
        float v = chk_dot(F.HB + (size_t)row * D, F.WupT + (size_t)col * D, D, l) / sqrtf(F.ssH[row] / D + EPS); v = fmaxf(v, 0.f); v = v * v;
        chk_flag(F, 7, !chk_close(bf2f(F.U[(size_t)row * FF + col]), v, 0.03f, 0.03f)); }
}
__device__ __forceinline__ void chk_p5(Frame& F_) {
    Frame F = F_; { int l_ = threadIdx.x; asm volatile("" : "+v"(l_)); F.tid = l_; F.lane = l_ & 63; }
    const int gw = F.vcu * NWAVES + F.wave, l = F.lane;
    for (int it = 0; it < 8; ++it) { const unsigned hsh = chk_hash(gw * 8 + it + 8888); const int row = hsh % M, col = (hsh >> 16) % D;
        const float ref = bf2f(F.HB[(size_t)row * D + col]) + chk_dot(F.U + (size_t)row * FF, F.WdnT + (size_t)col * FF, FF, l);
        chk_flag(F, 8, !chk_close(F.out[(size_t)row * D + col], ref, 0.06f, 0.03f)); }
    { const int row = (int)(chk_hash(gw + 4441) % M); float s2 = 0.f; for (int k = l; k < D; k += 64) { const float v = F.out[(size_t)row * D + k]; s2 += v * v; }
      s2 = wave_sum(s2); chk_flag(F, 9, !chk_close(F.ssO[row], s2, 0.f, 1e-3f)); }
}
__device__ __forceinline__ void chk_p6(Frame& F_) {
    Frame F = F_; { int l_ = threadIdx.x; asm volatile("" : "+v"(l_)); F.tid = l_; F.lane = l_ & 63; }
    const int gw = F.vcu * NWAVES + F.wave, l = F.lane;
    const int row = (int)(chk_hash(gw + 2718) % M); float s2 = 0.f; for (int k = l; k < D; k += 64) { const float v = F.out[(size_t)row * D + k] / F.g_fin[k]; s2 += v * v; }
    s2 = wave_sum(s2) / D; chk_flag(F, 10, !chk_close(s2, 1.f, 0.f, 2e-3f));
}
#endif

struct Args { const float* in[13]; float* out; unsigned char* ws; };
__global__ void __launch_bounds__(NWAVES * 64, 2) hyb_fwd(Args args) {
    extern __shared__ __attribute__((aligned(16))) unsigned char lds[];
    Frame F;
    F.lds = (LAS unsigned char*)lds;
    F.MISC = (volatile LAS unsigned*)(F.lds + MISC_OFF);
    F.tid = threadIdx.x; F.lane = F.tid & 63; F.wave = __builtin_amdgcn_readfirstlane(F.tid >> 6);
    F.G = gridDim.x; { const int bx = blockIdx.x; F.vcu = (F.G % 8 == 0) ? (bx % 8) * (F.G / 8) + bx / 8 : bx; }
    unsigned char* ws = args.ws;
    F.ctl = (gu32*)(ws + WS_CTL);
    F.x = args.in[0]; F.g_attn = args.in[1]; F.w_in = args.in[2]; F.gq = args.in[3]; F.gk = args.in[4]; F.rel_bias = args.in[5]; F.g_oa = args.in[6]; F.g_ob = args.in[7];
    F.w_out = args.in[8]; F.g_mlp = args.in[9]; F.w_up = args.in[10]; F.w_dn = args.in[11]; F.g_fin = args.in[12]; F.out = args.out;
    F.WinT = (bf16*)(ws + WS_WIN); F.WoutT = (bf16*)(ws + WS_WOUT); F.WupT = (bf16*)(ws + WS_WUP); F.WdnT = (bf16*)(ws + WS_WDN);
    F.HB = (bf16*)(ws + WS_HB); F.XN = (bf16*)(ws + WS_XN); F.QA = (bf16*)(ws + WS_QA); F.KA = (bf16*)(ws + WS_KA); F.VA = (bf16*)(ws + WS_VA);
    F.QB = (bf16*)(ws + WS_QB); F.KB = (bf16*)(ws + WS_KB); F.VB = (bf16*)(ws + WS_VB); F.Y = (bf16*)(ws + WS_Y); F.PB = (bf16*)(ws + WS_PB); F.U = (bf16*)(ws + WS_U);
    F.LB = (float*)(ws + WS_LB); F.ssH = (float*)(ws + WS_SSH); F.ssO = (float*)(ws + WS_SSO);
    F.cosT = (float*)(ws + WS_TAB + TAB_COS); F.sinT = (float*)(ws + WS_TAB + TAB_SIN); F.biasT = (float*)(ws + WS_TAB + TAB_BIAS);
    for (int u = F.tid; u < (LDS_BYTES - LDSCTL_OFF) / 4; u += NWAVES * 64) ((LAS unsigned*)(F.lds + LDSCTL_OFF))[u] = 0u;
    __syncthreads();
    XcdBarrier bar = xcd_barrier_post((unsigned*)(F.ctl + CW_BAR), F.MISC + 8);
#define GRID_BAR() xcd_barrier(bar)

    p0_prologue(F);
    GRID_BAR();
#if MK_CHECK
    chk_p0(F); GRID_BAR();
#endif

    {
        pg8::Gemm g{F.XN, F.WinT, M, NIN, D}; pg8::StaticOrder S; S.init(M, NIN, F.G, (int)blockIdx.x);
        pg8::EpiQKV E{F.QA, F.KA, F.VA, F.QB, F.KB, F.VB, F.gq, F.gk, F.cosT, F.sinT};
        pg8::gemm_phase<pg8::EpiQKV, pg8::StaticOrder, PG8_ALIGN, PG8_SP2>(F.lds + RING_OFF, g, S, E);
    }
    GRID_BAR();
#if MK_CHECK
    chk_p1(F); GRID_BAR();
#endif

    {
        for (int U = F.vcu; U < BATCH * 8 * 8; U += F.G) {
            const int bk = U >> 5, w = U & 31, b = bk >> 1, kvh = bk & 1, hq = kvh * 4 + (w >> 3), qb = w & 7;
            attn_body::attn_unit<8>(b, hq, kvh, qb, (const attn_body::bf16*)F.QA, (const attn_body::bf16*)F.KA, (const attn_body::bf16*)F.VA, (attn_body::bf16*)F.Y, (char*)lds + RING_OFF);
        }
        LAS float* bt = (LAS float*)(F.lds + RING_OFF);
        for (int i = F.tid; i < 3 * 8 * 132; i += NWAVES * 64) bt[i] = F.biasT[i];
        __syncthreads();
        LAS char* wl = (LAS char*)(F.lds + RING_OFF + 16384 + 8192 * F.wave);
        const int gw = F.vcu * NWAVES + F.wave, NGW = F.G * NWAVES;
        for (int u = gw; u < BATCH * 8 * 192; u += NGW) {
            const int bh = u / 192, rest = u - bh * 192, br = rest >> 6, idx = rest & 63, b = bh >> 3, h = bh & 7;
            const int r = br == 0 ? 1 : br == 1 ? 4 : 16, p = br == 0 ? 0 : br == 1 ? (idx >> 4) : (idx >> 2), qblk = br == 0 ? idx : br == 1 ? (idx & 15) : (idx & 3);
            dil::unit(b, h, r, p, qblk, F.QB, F.KB, F.VB, F.PB + (size_t)br * M * 512, F.LB + (size_t)br * M * 8, wl, bt + (br * 8 + h) * dil::BT_STRIDE);
        }
    }
    GRID_BAR();
    p2n_rows(F);
    GRID_BAR();
#if MK_CHECK
    chk_p2(F); GRID_BAR();
#endif

    {
        pg8::Gemm g{F.Y, F.WoutT, M, D, D}; pg8::StaticOrder S; S.init(M, D, F.G, (int)blockIdx.x);
        pg8::EpiRes<true> E{F.x, F.out, F.HB, F.ssH};
        pg8::gemm_phase<pg8::EpiRes<true>, pg8::StaticOrder, PG8_ALIGN, PG8_SP2>(F.lds + RING_OFF, g, S, E);
    }
    GRID_BAR();
#if MK_CHECK
    chk_p3(F); GRID_BAR();
#endif

    {
        pg8::Gemm g{F.HB, F.WupT, M, FF, D}; pg8::StaticOrder S; S.init(M, FF, F.G, (int)blockIdx.x);
        pg8::EpiUp E{F.U, F.ssH};
        pg8::gemm_phase<pg8::EpiUp, pg8::StaticOrder, PG8_ALIGN, PG8_SP2>(F.lds + RING_OFF, g, S, E);
    }
    GRID_BAR();
#if MK_CHECK
    chk_p4(F); GRID_BAR();
#endif

    {
        pg8::Gemm g{F.U, F.WdnT, M, D, FF}; pg8::StaticOrder S; S.init(M, D, F.G, (int)blockIdx.x);
        pg8::EpiRes<false> E{F.out, F.out, nullptr, F.ssO};
        pg8::gemm_phase<pg8::EpiRes<false>, pg8::StaticOrder, PG8_ALIGN, PG8_SP2>(F.lds + RING_OFF, g, S, E);
    }
    GRID_BAR();
#if MK_CHECK
    chk_p5(F); GRID_BAR();
#endif

    p6_rows(F);
#if MK_CHECK
    GRID_BAR(); chk_p6(F); GRID_BAR();
    if (blockIdx.x == 0 && F.tid == 0) {
        unsigned code = 0;
        for (int k = 15; k >= 0; --k) if (__hip_atomic_load(F.ctl + CW_ERR + k, RLX_AGENT) != 0u) code = (unsigned)k + 1u;
        if (__hip_atomic_load((gu32*)((unsigned*)(F.ctl + CW_BAR) + XB_TMO), RLX_AGENT) != 0u) code = 50u;
        if (code) F.out[0] = 1000.f * (float)code;
    }
#endif
#undef GRID_BAR
}

extern "C" void kernel_launch(void* const* d_in, const int* in_sizes, int n_in, void* d_out, int out_size, void* d_ws, size_t ws_size, hipStream_t stream) {
    static int grid = 0;
    if (grid == 0) {
        if (n_in != 13 || in_sizes[0] != M * D || out_size != M * D || ws_size < WS_END) { fprintf(stderr, "kernel_launch: built for 13 inputs, x and out of %d floats, >= %zu bytes of workspace; got n_in %d, in0 %d, out %d, ws %zu; nothing launched\n", M * D, (size_t)WS_END, n_in, n_in > 0 ? in_sizes[0] : -1, out_size, ws_size); grid = -1; return; }
        int dev = 0, cus = 0, per_cu = 0;
        if (hipGetDevice(&dev) != hipSuccess || hipDeviceGetAttribute(&cus, hipDeviceAttributeMultiprocessorCount, dev) != hipSuccess) { fprintf(stderr, "kernel_launch: hipGetDevice / hipDeviceGetAttribute failed; nothing launched\n"); grid = -1; return; }
        if (hipFuncSetAttribute((const void*)hyb_fwd, hipFuncAttributeMaxDynamicSharedMemorySize, LDS_BYTES) != hipSuccess) { fprintf(stderr, "kernel_launch: hipFuncSetAttribute failed\n"); grid = -1; return; }
        if (hipOccupancyMaxActiveBlocksPerMultiprocessor(&per_cu, (const void*)hyb_fwd, NWAVES * 64, LDS_BYTES) != hipSuccess || per_cu < 1) { fprintf(stderr, "kernel_launch: occupancy query reports %d workgroups per CU; nothing launched\n", per_cu); (void)hipGetLastError(); grid = -1; return; }
        (void)hipGetLastError();
        grid = cus;
        if (grid % 8 != 0) fprintf(stderr, "kernel_launch: note: %d CUs (not a multiple of 8)\n", grid);
    }
    if (grid < 0) return;
    if (hipMemsetAsync((char*)d_ws + WS_CTL, 0, CTL_ZERO_BYTES, stream) != hipSuccess) { fprintf(stderr, "kernel_launch: hipMemsetAsync of the control words failed; nothing launched\n"); return; }
    Args a{};
    for (int i = 0; i < 13; ++i) a.in[i] = (const float*)d_in[i];
    a.out = (float*)d_out; a.ws = (unsigned char*)d_ws;
    hipLaunchKernelGGL(hyb_fwd, dim3(grid), dim3(NWAVES * 64), LDS_BYTES, stream, a);
    const hipError_t le = hipPeekAtLastError();
    if (le != hipSuccess) fprintf(stderr, "kernel_launch: launch failed: %s (grid %d x %d threads, %d B LDS)\n", hipGetErrorName(le), grid, NWAVES * 64, LDS_BYTES);
}
```
